# Optimizing an MI355X kernel written in HIP

```python
import jax, jax.numpy as jnp
from jax import lax
import numpy as np

D_MODEL = 4096
BATCH = 8
SEQ = 2048
DEPTH = 1
DEC_BATCH = 2
DEC_SEQ = 4096
PAST_LEN = 128

HEAD_DIM = 128
N_Q_HEADS = 16
N_KV_HEADS = 4
Q_GROUP = N_Q_HEADS // N_KV_HEADS
Q_WIDTH = N_Q_HEADS * HEAD_DIM
KV_WIDTH = N_KV_HEADS * HEAD_DIM
Q_BLOCK = 128
ROPE_THETA = 10000.0
GRID_W = 64
POOL_WINDOWS = (2, 4, 8, 16)
N_POOL_GROUPS = len(POOL_WINDOWS)
POOL_WIDTH = D_MODEL // 2
POOL_GROUP_C = POOL_WIDTH // N_POOL_GROUPS
POOL_OUT_C = D_MODEL // N_POOL_GROUPS
N_BRANCHES = 2
IN_WIDTH = Q_WIDTH + 2 * KV_WIDTH + POOL_WIDTH + N_BRANCHES * D_MODEL
D_FF = 11008
CONV_W = 3
EPS = 1e-6

kernel_name = "hybrid_gqa_pool_convglu_encoder"


def rmsnorm(x, g):
    xf = x.astype(jnp.float32)
    inv = lax.rsqrt(jnp.mean(xf * xf, axis=-1, keepdims=True) + EPS)
    return (xf * inv * g.astype(jnp.float32)).astype(x.dtype)


def axial_rope(x, s):
    rows = s // GRID_W
    half = HEAD_DIM // 2
    quarter = half // 2
    inv_freq = ROPE_THETA ** (-jnp.arange(0, half, 2, dtype=jnp.float32) / half)
    row = jnp.repeat(jnp.arange(rows, dtype=jnp.float32), GRID_W)
    col = jnp.tile(jnp.arange(GRID_W, dtype=jnp.float32), rows)
    ang_r = row[:, None] * inv_freq[None, :]
    ang_c = col[:, None] * inv_freq[None, :]
    ang = jnp.concatenate([ang_r, ang_r, ang_c, ang_c], axis=-1)
    cos = jnp.cos(ang)[None, :, None, :]
    sin = jnp.sin(ang)[None, :, None, :]
    xf = x.astype(jnp.float32)
    xr = xf.reshape(xf.shape[:-1] + (2, 2, quarter))
    rot = jnp.stack([-xr[..., 1, :], xr[..., 0, :]], axis=-2).reshape(xf.shape)
    return (xf * cos + rot * sin).astype(x.dtype)


def blocked_gqa(q, k, v):
    b, s = q.shape[0], q.shape[1]
    nb = s // Q_BLOCK
    scale = HEAD_DIM ** -0.5
    qb = q.reshape(b, nb, Q_BLOCK, N_KV_HEADS, Q_GROUP, HEAD_DIM).transpose(1, 0, 2, 3, 4, 5)

    def one_block(q_blk):
        sc = jnp.einsum('bqkgd,bskd->bkgqs', q_blk, k).astype(jnp.float32) * scale
        p = jax.nn.softmax(sc, axis=-1).astype(v.dtype)
        return jnp.einsum('bkgqs,bskd->bqkgd', p, v)

    o = lax.map(one_block, qb)
    return o.transpose(1, 0, 2, 3, 4, 5).reshape(b, s, Q_WIDTH)


def multiscale_pool(u):
    s = u.shape[1]
    cs = jnp.cumsum(u.astype(jnp.float32), axis=1)
    cs = jnp.concatenate([jnp.zeros_like(cs[:, :1]), cs], axis=1)
    t = jnp.arange(s)[:, None]
    w = jnp.array(POOL_WINDOWS, dtype=jnp.int32)[None, :]
    lo = jnp.clip(t - w // 2, 0, s)
    hi = jnp.clip(t + w - w // 2, 0, s)
    g_idx = jnp.arange(N_POOL_GROUPS)[None, :]
    window_sum = cs[:, hi, g_idx] - cs[:, lo, g_idx]
    count = (hi - lo).astype(jnp.float32)[None, :, :, None]
    return (window_sum / count - u.astype(jnp.float32)).astype(u.dtype)


def token_mixer(n, w_in, q_norm_g, k_norm_g, w_attn_proj, w_pool, pool_scale, w_out):
    b, s, _ = n.shape
    proj = n @ w_in
    o1 = Q_WIDTH
    o2 = o1 + KV_WIDTH
    o3 = o2 + KV_WIDTH
    o4 = o3 + POOL_WIDTH
    q = proj[..., :o1].reshape(b, s, N_Q_HEADS, HEAD_DIM)
    k = proj[..., o1:o2].reshape(b, s, N_KV_HEADS, HEAD_DIM)
    v = proj[..., o2:o3].reshape(b, s, N_KV_HEADS, HEAD_DIM)
    u = proj[..., o3:o4].reshape(b, s, N_POOL_GROUPS, POOL_GROUP_C)
    g_attn = proj[..., o4:o4 + D_MODEL]
    g_pool = proj[..., o4 + D_MODEL:]
    q = axial_rope(rmsnorm(q, q_norm_g), s)
    k = axial_rope(rmsnorm(k, k_norm_g), s)
    attn = blocked_gqa(q, k, v) @ w_attn_proj
    d = multiscale_pool(u)
    pool = jnp.einsum('bsgc,gce->bsge', d, w_pool).reshape(b, s, D_MODEL) * pool_scale
    merged = jax.nn.sigmoid(g_attn) * attn + jax.nn.sigmoid(g_pool) * pool
    return merged @ w_out


def channel_mixer(n, w_up, conv_w, conv_b, w_down):
    up = n @ w_up
    up_p = jnp.pad(up, ((0, 0), (1, 1), (0, 0)))
    c = up_p[:, :-2] * conv_w[0] + up_p[:, 1:-1] * conv_w[1] + up_p[:, 2:] * conv_w[2] + conv_b
    gate, val = c[..., :D_FF], c[..., D_FF:]
    return (jax.nn.silu(gate) * val) @ w_down


def setup_inputs(seed: int = 0) -> dict:
    key = jax.random.key(seed)
    ks = jax.random.split(key, 16)
    f = jnp.float32

    def nrm(k, shape, fan_in):
        return jax.random.normal(k, shape, f) * (fan_in ** -0.5)

    return {
        "x_prompt": jax.random.normal(ks[0], (BATCH, SEQ, D_MODEL), f),
        "x_sample": jax.random.normal(ks[1], (DEC_BATCH, DEC_SEQ, D_MODEL), f),
        "norm_mix_g": 1.0 + 0.02 * jax.random.normal(ks[2], (DEPTH, D_MODEL), f),
        "w_in": nrm(ks[3], (DEPTH, D_MODEL, IN_WIDTH), D_MODEL),
        "q_norm_g": 1.0 + 0.02 * jax.random.normal(ks[4], (DEPTH, HEAD_DIM), f),
        "k_norm_g": 1.0 + 0.02 * jax.random.normal(ks[5], (DEPTH, HEAD_DIM), f),
        "w_attn_proj": nrm(ks[6], (DEPTH, Q_WIDTH, D_MODEL), Q_WIDTH),
        "w_pool": nrm(ks[7], (DEPTH, N_POOL_GROUPS, POOL_GROUP_C, POOL_OUT_C), POOL_GROUP_C),
        "pool_scale": 1.0 + 0.02 * jax.random.normal(ks[8], (DEPTH, D_MODEL), f),
        "w_out": nrm(ks[9], (DEPTH, D_MODEL, D_MODEL), D_MODEL),
        "norm_ffn_g": 1.0 + 0.02 * jax.random.normal(ks[10], (DEPTH, D_MODEL), f),
        "w_up": nrm(ks[11], (DEPTH, D_MODEL, 2 * D_FF), D_MODEL),
        "conv_w": nrm(ks[12], (DEPTH, CONV_W, 2 * D_FF), CONV_W),
        "conv_b": 0.02 * jax.random.normal(ks[13], (DEPTH, 2 * D_FF), f),
        "w_down": nrm(ks[14], (DEPTH, D_FF, D_MODEL), D_FF),
        "norm_final_g": 1.0 + 0.02 * jax.random.normal(ks[15], (D_MODEL,), f),
    }


def reference(x_prompt, x_sample, norm_mix_g, w_in, q_norm_g, k_norm_g, w_attn_proj, w_pool,
              pool_scale, w_out, norm_ffn_g, w_up, conv_w, conv_b, w_down, norm_final_g):
    def trunk(x):
        h = x
        for l in range(DEPTH):
            h = h + token_mixer(rmsnorm(h, norm_mix_g[l]), w_in[l], q_norm_g[l], k_norm_g[l],
                                w_attn_proj[l], w_pool[l], pool_scale[l], w_out[l])
            h = h + channel_mixer(rmsnorm(h, norm_ffn_g[l]), w_up[l], conv_w[l], conv_b[l], w_down[l])
        return rmsnorm(h, norm_final_g)

    y_prompt = trunk(x_prompt)
    y_sample = trunk(x_sample)
    return (y_prompt, y_sample)
```

```cpp
#include <hip/hip_runtime.h>
#include <cstdio>
#include <cstdint>
namespace pg8 {
#define PG8_LAS __attribute__((address_space(3)))
#define PG8_GAS __attribute__((address_space(1)))
typedef unsigned short bf16_t;
typedef short bf16x8 __attribute__((ext_vector_type(8)));
typedef float f32x4 __attribute__((ext_vector_type(4)));
typedef unsigned u32x4 __attribute__((ext_vector_type(4)));
constexpr int BM = 256, BK = 64, HALF = 128, HTB = HALF * BK * 2  , STAGE_BYTES = 8 * HTB, NXCD = 8, WGM = 4;
constexpr int XL_OFF = STAGE_BYTES + 1024;

__host__ __device__ __forceinline__ int lds_byte(int r, int c) { const int st = (r >> 4) * 2 + (c >> 5), rr = r & 15, cc = c & 31, ob = rr * 64 + cc * 2; return st * 1024 + (ob ^ (((ob >> 9) & 1) << 5)); }
__host__ __device__ __forceinline__ void stage_rc(int b, int& R, int& C) { const int st = b / 1024, sb = b % 1024, swz = sb ^ (((sb >> 9) & 1) << 5); R = (st >> 1) * 16 + swz / 64; C = (st & 1) * 32 + (swz % 64) / 2; }
__host__ __device__ __forceinline__ int perm32(int rho) { const int n = rho >> 4, i = rho & 15; return 8 * (i >> 2) + 4 * n + (i & 3); }

struct Unit { int pm, pn; };
struct Gemm { const bf16_t* A; const bf16_t* Bt; int lda, ldb, K; int gshift; unsigned goff; };

struct StaticOrder {
    int nM, nN, nwg, G, c, lim;
    __host__ __device__ void init(int M, int N, int G_, int c_) { nM = M / BM; nN = N / BM; nwg = nM * nN; G = G_; c = c_; lim = nwg; }
    __host__ __device__ bool next(int i, Unit& u) const {
        const long L = (long)i * G + c; if (L >= lim) return false;
        int wgid = (int)L; { const int q = nwg / NXCD, r = nwg % NXCD, xcd = wgid % NXCD, off = wgid / NXCD; wgid = (xcd < r ? xcd * (q + 1) : r * (q + 1) + (xcd - r) * q) + off; }
        const int nig = WGM * nN, gid = wgid / nig, fm = gid * WGM, gsz = (nM - fm) < WGM ? (nM - fm) : WGM;
        u.pm = fm + ((wgid % nig) % gsz); u.pn = (wgid % nig) / gsz; return true;
    }
    __device__ __forceinline__ void a_ready(const Unit&) const {}
    __device__ __forceinline__ void done(const Unit&) const {}
};


typedef float f32x2c __attribute__((ext_vector_type(2)));
typedef __bf16 bf16x2c __attribute__((ext_vector_type(2)));
__device__ __forceinline__ unsigned cvt_pk_bf16(float lo, float hi) { const f32x2c v = {lo, hi}; return __builtin_bit_cast(unsigned, __builtin_convertvector(v, bf16x2c)); }
__device__ __forceinline__ float bf_lo(unsigned w) { return __uint_as_float(w << 16); }
__device__ __forceinline__ float bf_hi(unsigned w) { return __uint_as_float(w & 0xffff0000u); }
__device__ __forceinline__ float sigmoidf_fast(float x) { return __builtin_amdgcn_rcpf(1.0f + __builtin_amdgcn_exp2f(-1.4426950408889634f * x)); }

struct EpiBf16 {
    static constexpr bool PERM = true, AFTER_DRAIN = false, USES_LDS = false;
    bf16_t* O; int ldc;
    __device__ __forceinline__ void operator()(const f32x4 (&acc)[2][2][4][2], const Unit& u, int wr, int wc, int fr, int fq) const {
        const int row0 = u.pm * BM + wr * 64 + fr, col0 = u.pn * BM + wc * 32 + 8 * fq;
#pragma unroll
        for (int ai = 0; ai < 2; ++ai)
#pragma unroll
            for (int m = 0; m < 4; ++m) { bf16_t* rowp = O + (size_t)(row0 + ai * HALF + m * 16) * ldc + col0;
#pragma unroll
                for (int bj = 0; bj < 2; ++bj) { const f32x4 v0 = acc[ai][bj][m][0], v1 = acc[ai][bj][m][1];
                    u32x4 w; w.x = cvt_pk_bf16(v0[0], v0[1]); w.y = cvt_pk_bf16(v0[2], v0[3]); w.z = cvt_pk_bf16(v1[0], v1[1]); w.w = cvt_pk_bf16(v1[2], v1[3]);
                    *(u32x4*)(rowp + bj * HALF) = w; } }
    }
};
struct EpiProj {
    static constexpr bool PERM = true, AFTER_DRAIN = false, USES_LDS = false;
    bf16_t *q, *k, *v, *u, *sa, *sp;
    __device__ __forceinline__ void operator()(const f32x4 (&acc)[2][2][4][2], const Unit& un, int wr, int wc, int fr, int fq) const {
        const int pn = un.pn; bf16_t* base; int ldc, ct; bool sg = false;
        if (pn < 8) { base = q; ldc = 2048; ct = pn; } else if (pn < 10) { base = k; ldc = 512; ct = pn - 8; } else if (pn < 12) { base = v; ldc = 512; ct = pn - 10; }
        else if (pn < 20) { base = u; ldc = 2048; ct = pn - 12; } else if (pn < 36) { base = sa; ldc = 4096; ct = pn - 20; sg = true; } else { base = sp; ldc = 4096; ct = pn - 36; sg = true; }
        const int row0 = un.pm * BM + wr * 64 + fr, col0 = ct * BM + wc * 32 + 8 * fq;
#pragma unroll
        for (int ai = 0; ai < 2; ++ai)
#pragma unroll
            for (int m = 0; m < 4; ++m) { bf16_t* rowp = base + (size_t)(row0 + ai * HALF + m * 16) * ldc + col0;
#pragma unroll
                for (int bj = 0; bj < 2; ++bj) { f32x4 v0 = acc[ai][bj][m][0], v1 = acc[ai][bj][m][1];
                    if (sg) {
#pragma unroll
                        for (int e = 0; e < 4; ++e) { v0[e] = sigmoidf_fast(v0[e]); v1[e] = sigmoidf_fast(v1[e]); } }
                    u32x4 w; w.x = cvt_pk_bf16(v0[0], v0[1]); w.y = cvt_pk_bf16(v0[2], v0[3]); w.z = cvt_pk_bf16(v1[0], v1[1]); w.w = cvt_pk_bf16(v1[2], v1[3]);
                    *(u32x4*)(rowp + bj * HALF) = w; } }
    }
};
struct EpiProj8 {
    static constexpr bool PERM = true, AFTER_DRAIN = false, USES_LDS = false;
    bf16_t *q, *k, *v, *sa, *sp; float scale;
    __device__ __forceinline__ void operator()(const f32x4 (&acc)[2][2][4][2], const Unit& un, int wr, int wc, int fr, int fq) const {
        const int pn = un.pn; bf16_t* base; int ldc, ct; bool sg = false;
        if (pn < 8) { base = q; ldc = 2048; ct = pn; } else if (pn < 10) { base = k; ldc = 512; ct = pn - 8; } else if (pn < 12) { base = v; ldc = 512; ct = pn - 10; }
        else if (pn < 28) { base = sa; ldc = 4096; ct = pn - 12; sg = true; } else { base = sp; ldc = 4096; ct = pn - 28; sg = true; }
        const int row0 = un.pm * BM + wr * 64 + fr, col0 = ct * BM + wc * 32 + 8 * fq;
#pragma unroll
        for (int ai = 0; ai < 2; ++ai)
#pragma unroll
            for (int m = 0; m < 4; ++m) { bf16_t* rowp = base + (size_t)(row0 + ai * HALF + m * 16) * ldc + col0;
#pragma unroll
                for (int bj = 0; bj < 2; ++bj) { f32x4 v0 = acc[ai][bj][m][0] * scale, v1 = acc[ai][bj][m][1] * scale;
                    if (sg) {
#pragma unroll
                        for (int e = 0; e < 4; ++e) { v0[e] = sigmoidf_fast(v0[e]); v1[e] = sigmoidf_fast(v1[e]); } }
                    u32x4 w; w.x = cvt_pk_bf16(v0[0], v0[1]); w.y = cvt_pk_bf16(v0[2], v0[3]); w.z = cvt_pk_bf16(v1[0], v1[1]); w.w = cvt_pk_bf16(v1[2], v1[3]);
                    *(PG8_GAS u32x4*)(rowp + bj * HALF) = w; } }
    }
};
struct EpiPool {
    static constexpr bool PERM = true, AFTER_DRAIN = false, USES_LDS = false;
    bf16_t* sp; const float* ps;
    __device__ __forceinline__ void operator()(const f32x4 (&acc)[2][2][4][2], const Unit& un, int wr, int wc, int fr, int fq) const {
        const int row0 = un.pm * BM + wr * 64 + fr, col0 = un.pn * BM + wc * 32 + 8 * fq;
        f32x4 sc[2][2];
#pragma unroll
        for (int bj = 0; bj < 2; ++bj)
#pragma unroll
            for (int n = 0; n < 2; ++n) sc[bj][n] = *(const PG8_GAS f32x4*)(ps + col0 + bj * HALF + 4 * n);
#pragma unroll
        for (int ai = 0; ai < 2; ++ai) {
            u32x4 gg[4][2];
#pragma unroll
            for (int m = 0; m < 4; ++m)
#pragma unroll
                for (int bj = 0; bj < 2; ++bj) gg[m][bj] = *(const PG8_GAS u32x4*)(sp + (size_t)(row0 + ai * HALF + m * 16) * 4096 + col0 + bj * HALF);
            asm volatile("" ::: "memory");
#pragma unroll
            for (int m = 0; m < 4; ++m)
#pragma unroll
                for (int bj = 0; bj < 2; ++bj) { const u32x4 g = gg[m][bj];
                    const f32x4 v0 = acc[ai][bj][m][0] * sc[bj][0], v1 = acc[ai][bj][m][1] * sc[bj][1];
                    u32x4 w; w.x = cvt_pk_bf16(v0[0] * bf_lo(g.x), v0[1] * bf_hi(g.x)); w.y = cvt_pk_bf16(v0[2] * bf_lo(g.y), v0[3] * bf_hi(g.y));
                    w.z = cvt_pk_bf16(v1[0] * bf_lo(g.z), v1[1] * bf_hi(g.z)); w.w = cvt_pk_bf16(v1[2] * bf_lo(g.w), v1[3] * bf_hi(g.w));
                    *(PG8_GAS u32x4*)(sp + (size_t)(row0 + ai * HALF + m * 16) * 4096 + col0 + bj * HALF) = w; }
        }
    }
};
struct EpiMerge {
    static constexpr bool PERM = true, AFTER_DRAIN = false, USES_LDS = false;
    bf16_t* sa; const bf16_t* P; float scale;
    __device__ __forceinline__ void operator()(const f32x4 (&acc)[2][2][4][2], const Unit& un, int wr, int wc, int fr, int fq) const {
        const int row0 = un.pm * BM + wr * 64 + fr, col0 = un.pn * BM + wc * 32 + 8 * fq;
#pragma unroll
        for (int ai = 0; ai < 2; ++ai) {
            u32x4 gg[4][2], pp[4][2];
#pragma unroll
            for (int m = 0; m < 4; ++m)
#pragma unroll
                for (int bj = 0; bj < 2; ++bj) { const size_t off = (size_t)(row0 + ai * HALF + m * 16) * 4096 + col0 + bj * HALF; gg[m][bj] = *(const PG8_GAS u32x4*)(sa + off); pp[m][bj] = *(const PG8_GAS u32x4*)(P + off); }
            asm volatile("" ::: "memory");
#pragma unroll
            for (int m = 0; m < 4; ++m)
#pragma unroll
                for (int bj = 0; bj < 2; ++bj) { const u32x4 g = gg[m][bj], p = pp[m][bj]; const f32x4 v0 = acc[ai][bj][m][0] * scale, v1 = acc[ai][bj][m][1] * scale;
                    u32x4 w; w.x = cvt_pk_bf16(v0[0] * bf_lo(g.x) + bf_lo(p.x), v0[1] * bf_hi(g.x) + bf_hi(p.x)); w.y = cvt_pk_bf16(v0[2] * bf_lo(g.y) + bf_lo(p.y), v0[3] * bf_hi(g.y) + bf_hi(p.y));
                    w.z = cvt_pk_bf16(v1[0] * bf_lo(g.z) + bf_lo(p.z), v1[1] * bf_hi(g.z) + bf_hi(p.z)); w.w = cvt_pk_bf16(v1[2] * bf_lo(g.w) + bf_lo(p.w), v1[3] * bf_hi(g.w) + bf_hi(p.w));
                    *(PG8_GAS u32x4*)(sa + (size_t)(row0 + ai * HALF + m * 16) * 4096 + col0 + bj * HALF) = w; }
        }
    }
};
struct EpiResF32 {
    static constexpr bool PERM = false, AFTER_DRAIN = false, USES_LDS = false;
    const float* base; const float* base2; int split_pm; float* out;
    __device__ __forceinline__ void operator()(const f32x4 (&acc)[2][2][4][2], const Unit& un, int wr, int wc, int fr, int fq) const {
        const int rloc = wr * 64 + fr, col0 = un.pn * BM + wc * 32 + 4 * fq;
        const float* bs = un.pm < split_pm ? base + (size_t)un.pm * BM * 4096 : base2 + (size_t)(un.pm - split_pm) * BM * 4096;
        float* os = out + (size_t)un.pm * BM * 4096;
#pragma unroll
        for (int ai = 0; ai < 2; ++ai)
#pragma unroll
            for (int m = 0; m < 4; ++m) { const size_t off = (size_t)(rloc + ai * HALF + m * 16) * 4096 + col0;
#pragma unroll
                for (int bj = 0; bj < 2; ++bj)
#pragma unroll
                    for (int n = 0; n < 2; ++n) { const f32x4 b = *(const f32x4*)(bs + off + bj * HALF + n * 16); *(f32x4*)(os + off + bj * HALF + n * 16) = b + acc[ai][bj][m][n]; } }
    }
};


struct EpiResNorm {
    static constexpr bool PERM = true, AFTER_DRAIN = false, USES_LDS = true, HALF_OK = true;
    const float* base; const float* base2; int split_pm; bf16_t* hb16; float* ssq;
    __device__ __forceinline__ void run(const f32x4 (&acc)[2][2][4][2], const Unit& un, int wr, int wc, int fr, int fq, PG8_LAS unsigned char* xl) const {
        asm volatile("" : "+v"(fr));
        const int rloc = wr * 64 + fr, col0 = un.pn * BM + wc * 32 + 8 * fq;
        const float* bs = un.pm < split_pm ? base + (size_t)un.pm * BM * 4096 : base2 + (size_t)(un.pm - split_pm) * BM * 4096;
        bf16_t* hs = hb16 + (size_t)un.pm * BM * 4096;
        PG8_LAS float* X = (PG8_LAS float*)xl;
#pragma unroll
        for (int ai = 0; ai < 2; ++ai) {
            f32x4 bb[4][2][2];
#pragma unroll
            for (int m = 0; m < 4; ++m)
#pragma unroll
                for (int bj = 0; bj < 2; ++bj)
#pragma unroll
                    for (int n = 0; n < 2; ++n) bb[m][bj][n] = *(const PG8_GAS f32x4*)(bs + (size_t)(rloc + ai * HALF + m * 16) * 4096 + col0 + bj * HALF + 4 * n);
            asm volatile("" ::: "memory");
#pragma unroll
            for (int m = 0; m < 4; ++m) { float s = 0.f;
#pragma unroll
                for (int bj = 0; bj < 2; ++bj) { const f32x4 h0 = bb[m][bj][0] + acc[ai][bj][m][0], h1 = bb[m][bj][1] + acc[ai][bj][m][1];
                    s += ((h0[0] * h0[0] + h0[1] * h0[1]) + (h0[2] * h0[2] + h0[3] * h0[3])) + ((h1[0] * h1[0] + h1[1] * h1[1]) + (h1[2] * h1[2] + h1[3] * h1[3]));
                    u32x4 w; w.x = cvt_pk_bf16(h0[0], h0[1]); w.y = cvt_pk_bf16(h0[2], h0[3]); w.z = cvt_pk_bf16(h1[0], h1[1]); w.w = cvt_pk_bf16(h1[2], h1[3]);
                    *(PG8_GAS u32x4*)(hs + (size_t)(rloc + ai * HALF + m * 16) * 4096 + col0 + bj * HALF) = w; }
                s += __shfl_xor(s, 16); s += __shfl_xor(s, 32);
                if (fq == 0) X[wc * 256 + rloc + ai * HALF + m * 16] = s; }
        }
        asm volatile("s_waitcnt lgkmcnt(0)" ::: "memory"); __builtin_amdgcn_s_barrier(); asm volatile("" ::: "memory");
        const int th = wc * 64 + fq * 16 + fr;
        if (th < 128) { const int t = wr * 64 + (th & 63) + (th >> 6) * 128; atomicAdd(ssq + (size_t)un.pm * BM + t, (X[t] + X[256 + t]) + (X[512 + t] + X[768 + t])); }
    }
};
struct EpiResBf16 {
    static constexpr bool PERM = true, AFTER_DRAIN = false, USES_LDS = false;
    bf16_t* h;
    __device__ __forceinline__ void operator()(const f32x4 (&acc)[2][2][4][2], const Unit& un, int wr, int wc, int fr, int fq) const {
        const int row0 = un.pm * BM + wr * 64 + fr, col0 = un.pn * BM + wc * 32 + 8 * fq;
        u32x4 rr[2][4][2];
#pragma unroll
        for (int ai = 0; ai < 2; ++ai)
#pragma unroll
            for (int m = 0; m < 4; ++m)
#pragma unroll
                for (int bj = 0; bj < 2; ++bj) rr[ai][m][bj] = *(const PG8_GAS u32x4*)((PG8_GAS bf16_t*)h + (size_t)(row0 + ai * HALF + m * 16) * 4096 + col0 + bj * HALF);
        asm volatile("" ::: "memory");
#pragma unroll
        for (int ai = 0; ai < 2; ++ai)
#pragma unroll
            for (int m = 0; m < 4; ++m)
#pragma unroll
                for (int bj = 0; bj < 2; ++bj) { const u32x4 r = rr[ai][m][bj]; const f32x4 v0 = acc[ai][bj][m][0], v1 = acc[ai][bj][m][1];
                    u32x4 w; w.x = cvt_pk_bf16(v0[0] + bf_lo(r.x), v0[1] + bf_hi(r.x)); w.y = cvt_pk_bf16(v0[2] + bf_lo(r.y), v0[3] + bf_hi(r.y));
                    w.z = cvt_pk_bf16(v1[0] + bf_lo(r.z), v1[1] + bf_hi(r.z)); w.w = cvt_pk_bf16(v1[2] + bf_lo(r.w), v1[3] + bf_hi(r.w));
                    *(PG8_GAS u32x4*)((PG8_GAS bf16_t*)h + (size_t)(row0 + ai * HALF + m * 16) * 4096 + col0 + bj * HALF) = w; }
    }
};
__device__ __forceinline__ float dpp_ror1(float x)  { return __int_as_float(__builtin_amdgcn_update_dpp(0, __float_as_int(x), 0x121, 0xf, 0xf, true)); }
__device__ __forceinline__ float dpp_ror15(float x) { return __int_as_float(__builtin_amdgcn_update_dpp(0, __float_as_int(x), 0x12f, 0xf, 0xf, true)); }
__device__ __forceinline__ float fma_s(float a, float b, float c) { float d; asm("v_fma_f32 %0, %1, %2, %3" : "=v"(d) : "v"(a), "v"(b), "v"(c)); return d; }
__device__ __forceinline__ float mul_s(float a, float b) { float d; asm("v_mul_f32 %0, %1, %2" : "=v"(d) : "v"(a), "v"(b)); return d; }
#define PG8_ROR1(x) dpp_ror1(x)
#define PG8_ROR15(x) dpp_ror15(x)
struct EpiConvGlu {
    static constexpr bool PERM = true, AFTER_DRAIN = false, USES_LDS = true, HALF_OK = false;
    bf16_t* act; float* hb; const float* cw; const float* cb; int dff, nup; const float* ssq; float inv_n, eps;
    __device__ __forceinline__ void run(f32x4 (&acc)[2][2][4][2], const Unit& un, int wr, int wc, int fr, int fq, PG8_LAS unsigned char* xl) const {
        asm volatile("" : "+v"(fr), "+v"(fq));
        const int cl = wc * 32 + 8 * fq;
#pragma unroll
        for (int ai = 0; ai < 2; ++ai)
#pragma unroll
            for (int m = 0; m < 4; ++m) { const float iv = 1.0f / sqrtf(ssq[(size_t)un.pm * BM + wr * 64 + fr + ai * HALF + m * 16] * inv_n + eps);
#pragma unroll
                for (int bj = 0; bj < 2; ++bj)
#pragma unroll
                    for (int n = 0; n < 2; ++n) acc[ai][bj][m][n] = acc[ai][bj][m][n] * iv; }
        PG8_LAS float* X = (PG8_LAS float*)xl;
#pragma unroll
        for (int ai = 0; ai < 2; ++ai) { const int blk = ai * 2 + wr;
            if (fr == 0) {
#pragma unroll
                for (int bj = 0; bj < 2; ++bj) { *(PG8_LAS f32x4*)(X + (blk * 2 + 0) * 256 + bj * 128 + cl) = acc[ai][bj][0][0]; *(PG8_LAS f32x4*)(X + (blk * 2 + 0) * 256 + bj * 128 + cl + 4) = acc[ai][bj][0][1]; } }
            if (fr == 15) {
#pragma unroll
                for (int bj = 0; bj < 2; ++bj) { *(PG8_LAS f32x4*)(X + (blk * 2 + 1) * 256 + bj * 128 + cl) = acc[ai][bj][3][0]; *(PG8_LAS f32x4*)(X + (blk * 2 + 1) * 256 + bj * 128 + cl + 4) = acc[ai][bj][3][1]; } } }
        asm volatile("s_waitcnt lgkmcnt(0)" ::: "memory"); __builtin_amdgcn_s_barrier(); asm volatile("" ::: "memory");
        { float* hrow = hb + ((size_t)un.pm * 4) * nup + (size_t)un.pn * 256 + cl;
          if (wr == 0 && fr < 2) {
#pragma unroll
              for (int bj = 0; bj < 2; ++bj) { *(f32x4*)(hrow + (size_t)fr * nup + bj * 128) = acc[0][bj][0][0]; *(f32x4*)(hrow + (size_t)fr * nup + bj * 128 + 4) = acc[0][bj][0][1]; } }
          if (wr == 1 && fr >= 14) {
#pragma unroll
              for (int bj = 0; bj < 2; ++bj) { *(f32x4*)(hrow + (size_t)(fr - 12) * nup + bj * 128) = acc[1][bj][3][0]; *(f32x4*)(hrow + (size_t)(fr - 12) * nup + bj * 128 + 4) = acc[1][bj][3][1]; } } }
        const bool e0 = fr == 0, e15 = fr == 15;
        const int row0 = un.pm * BM + wr * 64 + fr;
        typedef unsigned u32x2 __attribute__((ext_vector_type(2)));
#pragma unroll
        for (int ai = 0; ai < 2; ++ai) { const int blk = ai * 2 + wr;
            u32x2 keep[4];
#pragma unroll
            for (int n = 0; n < 2; ++n) {
                const int j = un.pn * 128 + cl + 4 * n;
                const f32x4 w0g = *(const PG8_GAS f32x4*)(cw + j), w1g = *(const PG8_GAS f32x4*)(cw + nup + j), w2g = *(const PG8_GAS f32x4*)(cw + 2 * (size_t)nup + j), bg = *(const PG8_GAS f32x4*)(cb + j);
                const f32x4 w0v = *(const PG8_GAS f32x4*)(cw + dff + j), w1v = *(const PG8_GAS f32x4*)(cw + nup + dff + j), w2v = *(const PG8_GAS f32x4*)(cw + 2 * (size_t)nup + dff + j), bv = *(const PG8_GAS f32x4*)(cb + dff + j);
                f32x4 hpg, hpv, hng, hnv;
                if (blk > 0) { hpg = *(const PG8_LAS f32x4*)(X + ((blk - 1) * 2 + 1) * 256 + cl + 4 * n); hpv = *(const PG8_LAS f32x4*)(X + ((blk - 1) * 2 + 1) * 256 + 128 + cl + 4 * n); } else { hpg = (f32x4){0.f, 0.f, 0.f, 0.f}; hpv = hpg; }
                if (blk < 3) { hng = *(const PG8_LAS f32x4*)(X + ((blk + 1) * 2 + 0) * 256 + cl + 4 * n); hnv = *(const PG8_LAS f32x4*)(X + ((blk + 1) * 2 + 0) * 256 + 128 + cl + 4 * n); } else { hng = (f32x4){0.f, 0.f, 0.f, 0.f}; hnv = hng; }
#pragma unroll
                for (int m = 0; m < 4; ++m) {
                    float o[4];
#pragma unroll
                    for (int e = 0; e < 4; ++e) {
                        const float g = acc[ai][0][m][n][e], v = acc[ai][1][m][n][e];
                        const float gpe = m > 0 ? PG8_ROR1(acc[ai][0][m - 1][n][e]) : hpg[e], vpe = m > 0 ? PG8_ROR1(acc[ai][1][m - 1][n][e]) : hpv[e];
                        const float gne = m < 3 ? PG8_ROR15(acc[ai][0][m + 1][n][e]) : hng[e], vne = m < 3 ? PG8_ROR15(acc[ai][1][m + 1][n][e]) : hnv[e];
                        const float gpi = PG8_ROR1(g), vpi = PG8_ROR1(v), gni = PG8_ROR15(g), vni = PG8_ROR15(v);
                        const float gp = e0 ? gpe : gpi, vp = e0 ? vpe : vpi, gn = e15 ? gne : gni, vn = e15 ? vne : vni;
                        const float cg = fma_s(w2g[e], gn, fma_s(w1g[e], g, fma_s(w0g[e], gp, bg[e]))), cv = fma_s(w2v[e], vn, fma_s(w1v[e], v, fma_s(w0v[e], vp, bv[e])));
                        o[e] = (cg * cv) * __builtin_amdgcn_rcpf(1.0f + __builtin_amdgcn_exp2f(cg * -1.4426950408889634f));
                    }
                    if (n == 0) { keep[m].x = cvt_pk_bf16(o[0], o[1]); keep[m].y = cvt_pk_bf16(o[2], o[3]); }
                    else { u32x4 w; w.x = keep[m].x; w.y = keep[m].y; w.z = cvt_pk_bf16(o[0], o[1]); w.w = cvt_pk_bf16(o[2], o[3]);
                        *(PG8_GAS u32x4*)(act + (size_t)(row0 + ai * HALF + m * 16) * dff + j - 4) = w; }
                }
                __builtin_amdgcn_sched_barrier(0);
            }
        }
    }
};

typedef int i32x4v __attribute__((ext_vector_type(4)));
typedef int i32x8v __attribute__((ext_vector_type(8)));
__device__ __forceinline__ i32x8v cat8(bf16x8 a, bf16x8 b) { return __builtin_shufflevector(__builtin_bit_cast(i32x4v, a), __builtin_bit_cast(i32x4v, b), 0, 1, 2, 3, 4, 5, 6, 7); }
template <class Epi, class Sched, bool ALIGN_EPI = false, bool SP2 = false, bool F8 = false>
__device__ __forceinline__ void gemm_phase(PG8_LAS unsigned char* lds, const Gemm g, const Sched& S, const Epi& E) {
    int tid_ = threadIdx.x; asm volatile("" : "+v"(tid_));
    const int tid = tid_, wid = __builtin_amdgcn_readfirstlane(tid >> 6), lane = tid & 63, wr = wid >> 2, wc = wid & 3, fr = lane & 15, fq = lane >> 4;
    const int K = g.K, nt = K / BK;
    unsigned voffA[2], voffB[2];
#pragma unroll
    for (int i = 0; i < 2; ++i) { int R, C; stage_rc(tid * 16 + i * 8192, R, C); const int Rb = Epi::PERM ? ((R & ~31) + perm32(R & 31)) : R;
        voffA[i] = (unsigned)(R * g.lda + C) * 2u; voffB[i] = (unsigned)(Rb * g.ldb + C) * 2u; }
    const size_t kstep = (size_t)(BK * 2);
    const size_t hA = (size_t)HALF * g.lda * 2, hB = (size_t)HALF * g.ldb * 2;
    const size_t tA = 2 * hA, tB = 2 * hB;
    const unsigned ldsw = (unsigned)wid * 1024u;
    const int aoff = lds_byte(wr * 64 + fr, fq * 8), boff = lds_byte(wc * 32 + fr, fq * 8);
#define PG8_SA(b, h) (((b) * 2 + (h)) * HTB)
#define PG8_SB(b, h) ((4 + (b) * 2 + (h)) * HTB)
#define PG8_STAGE(bufoff, gbase, voff) do { _Pragma("unroll") for (int _i = 0; _i < 2; ++_i) \
        __builtin_amdgcn_global_load_lds((const unsigned*)((const char*)(gbase) + (voff)[_i]), (PG8_LAS unsigned*)(lds + (bufoff) + ldsw + _i * 8192), 16, 0, 0); } while (0)
#define PG8_LDA(dst, b, h) do { _Pragma("unroll") for (int m = 0; m < 4; ++m) _Pragma("unroll") for (int k = 0; k < 2; ++k) dst[m][k] = *(const PG8_LAS bf16x8*)(lds + PG8_SA(b, h) + aoff + m * 2048 + k * 1024); } while (0)
#define PG8_LDB(dst, b, h) do { _Pragma("unroll") for (int n = 0; n < 2; ++n) _Pragma("unroll") for (int k = 0; k < 2; ++k) dst[n][k] = *(const PG8_LAS bf16x8*)(lds + PG8_SB(b, h) + boff + n * 2048 + k * 1024); } while (0)
#define PG8_MMA(ai, bj, At, Bt) do { __builtin_amdgcn_s_setprio(1); \
    if constexpr (F8) { _Pragma("unroll") for (int m = 0; m < 4; ++m) _Pragma("unroll") for (int n = 0; n < 2; ++n) { const i32x8v a8_ = cat8(At[m][0], At[m][1]), b8_ = cat8(Bt[n][0], Bt[n][1]); \
        asm volatile("v_mfma_scale_f32_16x16x128_f8f6f4 %0, %1, %2, %0, %3, %3 op_sel_hi:[0,0,0]" : "+v"(acc[ai][bj][m][n]) : "v"(b8_), "v"(a8_), "v"(one8)); } } \
    else { _Pragma("unroll") for (int m = 0; m < 4; ++m) _Pragma("unroll") for (int n = 0; n < 2; ++n) _Pragma("unroll") for (int k = 0; k < 2; ++k) \
        acc[ai][bj][m][n] = __builtin_amdgcn_mfma_f32_16x16x32_bf16(Bt[n][k], At[m][k], acc[ai][bj][m][n], 0, 0, 0); } \
    __builtin_amdgcn_s_setprio(0); } while (0)
#define PG8_WAIT_V(n) asm volatile("s_waitcnt vmcnt(" #n ")" ::: "memory")
#define PG8_WAIT_L(n) asm volatile("s_waitcnt lgkmcnt(" #n ")" ::: "memory")
#define PG8_BAR __builtin_amdgcn_s_barrier()
#define PG8_SCHED __builtin_amdgcn_sched_barrier(0)
    int one8 = 0x7f7f7f7f; asm volatile("" : "+v"(one8));
    Unit cur, nxt; int ui = 0;
    if (!S.next(0, cur)) return;
    f32x4 acc[2][2][4][2];
#pragma unroll
    for (int a = 0; a < 2; ++a)
#pragma unroll
        for (int b = 0; b < 2; ++b)
#pragma unroll
            for (int m = 0; m < 4; ++m)
#pragma unroll
                for (int n = 0; n < 2; ++n) acc[a][b][m][n] = (f32x4){0.f, 0.f, 0.f, 0.f};
    bf16x8 At[4][2], B0[2][2], B1[2][2];
    const char* cA = (const char*)g.A + (size_t)cur.pm * tA + (size_t)(cur.pn >> g.gshift) * g.goff; const char* cB = (const char*)g.Bt + (size_t)cur.pn * tB;
    S.a_ready(cur);
    if constexpr (SP2) {
        PG8_STAGE(PG8_SB(0, 0), cB, voffB); PG8_STAGE(PG8_SB(0, 1), cB + hB, voffB); PG8_STAGE(PG8_SA(0, 0), cA, voffA); PG8_STAGE(PG8_SA(0, 1), cA + hA, voffA);
        if (wr == 1) PG8_BAR;
        PG8_WAIT_V(2); PG8_BAR;
        PG8_STAGE(PG8_SB(1, 0), cB + kstep, voffB); PG8_STAGE(PG8_SA(1, 0), cA + kstep, voffA); PG8_STAGE(PG8_SB(1, 1), cB + hB + kstep, voffB);
        PG8_WAIT_V(6); PG8_BAR;
    } else {
        PG8_STAGE(PG8_SB(0, 0), cB, voffB); PG8_STAGE(PG8_SA(0, 0), cA, voffA); PG8_STAGE(PG8_SB(0, 1), cB + hB, voffB); PG8_STAGE(PG8_SA(0, 1), cA + hA, voffA);
        if (wr == 1) PG8_BAR;
        PG8_WAIT_V(4); PG8_BAR;
        PG8_STAGE(PG8_SB(1, 0), cB + kstep, voffB); PG8_STAGE(PG8_SA(1, 0), cA + kstep, voffA); PG8_STAGE(PG8_SB(1, 1), cB + hB + kstep, voffB);
        PG8_WAIT_V(6); PG8_BAR;
    }
    for (;;) {
        const bool has_next = S.next(ui + 1, nxt);
        const char* nA = has_next ? (const char*)g.A + (size_t)nxt.pm * tA + (size_t)(nxt.pn >> g.gshift) * g.goff : cA; const char* nB = has_next ? (const char*)g.Bt + (size_t)nxt.pn * tB : cB;
        for (int t = 0; t < nt; t += 2) {
            const bool last = (t == nt - 2);
            const char* a1 = cA + (size_t)(t + 1) * kstep;
            const char* a2 = last ? nA : cA + (size_t)(t + 2) * kstep; const char* b2 = last ? nB : cB + (size_t)(t + 2) * kstep;
            const char* a3 = a2 + kstep; const char* b3 = b2 + kstep;
            if (last && has_next) S.a_ready(nxt);
            if constexpr (SP2) {
            PG8_LDB(B0, 0, 0); PG8_LDB(B1, 0, 1); PG8_SCHED; PG8_LDA(At, 0, 0); PG8_STAGE(PG8_SA(1, 1), a1 + hA, voffA);
            PG8_WAIT_V(8); PG8_WAIT_L(0); PG8_BAR; PG8_MMA(0, 0, At, B0); PG8_MMA(0, 1, At, B1); PG8_BAR; PG8_SCHED;
            PG8_LDA(At, 0, 1); PG8_STAGE(PG8_SB(0, 0), b2, voffB); PG8_STAGE(PG8_SB(0, 1), b2 + hB, voffB); PG8_STAGE(PG8_SA(0, 0), a2, voffA);
            PG8_WAIT_V(8); PG8_WAIT_L(0); PG8_BAR; PG8_MMA(1, 0, At, B0); PG8_MMA(1, 1, At, B1); PG8_BAR; PG8_SCHED;
            PG8_LDB(B0, 1, 0); PG8_LDB(B1, 1, 1); PG8_SCHED; PG8_LDA(At, 1, 0); PG8_STAGE(PG8_SA(0, 1), a2 + hA, voffA);
            PG8_WAIT_V(8); PG8_WAIT_L(0); PG8_BAR; PG8_MMA(0, 0, At, B0); PG8_MMA(0, 1, At, B1); PG8_BAR; PG8_SCHED;
            PG8_LDA(At, 1, 1); PG8_STAGE(PG8_SB(1, 0), b3, voffB); PG8_STAGE(PG8_SB(1, 1), b3 + hB, voffB); PG8_STAGE(PG8_SA(1, 0), a3, voffA);
            PG8_WAIT_V(8); PG8_WAIT_L(0); PG8_BAR; PG8_MMA(1, 0, At, B0); PG8_MMA(1, 1, At, B1); PG8_BAR; PG8_SCHED;
            } else {
            PG8_LDB(B0, 0, 0); PG8_SCHED; PG8_LDA(At, 0, 0); PG8_STAGE(PG8_SA(1, 1), a1 + hA, voffA);
            PG8_WAIT_L(8); PG8_BAR; PG8_WAIT_L(0); PG8_MMA(0, 0, At, B0); PG8_BAR; PG8_SCHED;
            PG8_LDB(B1, 0, 1); PG8_STAGE(PG8_SB(0, 0), b2, voffB);
            PG8_BAR; PG8_WAIT_L(0); PG8_MMA(0, 1, At, B1); PG8_BAR;
            PG8_LDA(At, 0, 1); PG8_STAGE(PG8_SA(0, 0), a2, voffA);
            PG8_BAR; PG8_WAIT_L(0); PG8_MMA(1, 0, At, B0); PG8_BAR; PG8_SCHED;
            PG8_STAGE(PG8_SB(0, 1), b2 + hB, voffB);
            PG8_WAIT_V(6); PG8_BAR; PG8_MMA(1, 1, At, B1); PG8_BAR;
            PG8_LDB(B0, 1, 0); PG8_SCHED; PG8_LDA(At, 1, 0); PG8_STAGE(PG8_SA(0, 1), a2 + hA, voffA);
            PG8_WAIT_L(8); PG8_BAR; PG8_WAIT_L(0); PG8_MMA(0, 0, At, B0); PG8_BAR; PG8_SCHED;
            PG8_LDB(B1, 1, 1); PG8_STAGE(PG8_SB(1, 0), b3, voffB);
            PG8_BAR; PG8_WAIT_L(0); PG8_MMA(0, 1, At, B1); PG8_BAR;
            PG8_LDA(At, 1, 1); PG8_STAGE(PG8_SA(1, 0), a3, voffA);
            PG8_BAR; PG8_WAIT_L(0); PG8_MMA(1, 0, At, B0); PG8_BAR; PG8_SCHED;
            PG8_STAGE(PG8_SB(1, 1), b3 + hB, voffB);
            PG8_WAIT_V(6); PG8_BAR; PG8_MMA(1, 1, At, B1); PG8_BAR;
            }
        }
        if constexpr (ALIGN_EPI) { if (wr == 0) PG8_BAR; }
        if constexpr (F8) asm volatile("s_nop 15\n\ts_nop 15\n\ts_nop 7" ::: "memory");
        if constexpr (!Epi::AFTER_DRAIN) { if constexpr (Epi::USES_LDS) { static_assert(ALIGN_EPI || Epi::HALF_OK, "an epilogue whose exchange crosses the two halves needs them aligned"); E.run(acc, cur, wr, wc, fr, fq, lds + XL_OFF); } else E(acc, cur, wr, wc, fr, fq); S.done(cur); }
        if (!has_next) break;
#pragma unroll
        for (int a = 0; a < 2; ++a)
#pragma unroll
            for (int b = 0; b < 2; ++b)
#pragma unroll
                for (int m = 0; m < 4; ++m)
#pragma unroll
                    for (int n = 0; n < 2; ++n) acc[a][b][m][n] = (f32x4){0.f, 0.f, 0.f, 0.f};
        cur = nxt; cA = nA; cB = nB; ++ui;
        if constexpr (ALIGN_EPI) { if (wr == 1) PG8_BAR; }
    }
    PG8_WAIT_V(0);
    if constexpr (!ALIGN_EPI) { if (wr == 0) PG8_BAR; }
    PG8_BAR;
    if constexpr (Epi::AFTER_DRAIN) { E.fused(acc, cur, wr, wc, fr, fq, lds, wid, lane); S.done(cur); }
#undef PG8_SA
#undef PG8_SB
#undef PG8_STAGE
#undef PG8_LDA
#undef PG8_LDB
#undef PG8_MMA
#undef PG8_WAIT_V
#undef PG8_WAIT_L
#undef PG8_BAR
#undef PG8_SCHED
}
}

namespace att {
#define ATT_LAS __attribute__((address_space(3)))
typedef unsigned short bf16_t;
using bf16x8 = __attribute__((ext_vector_type(8))) short;
using s16x4  = __attribute__((ext_vector_type(4))) short;
using f32x16 = __attribute__((ext_vector_type(16))) float;
using u32x4  = __attribute__((ext_vector_type(4))) unsigned;
constexpr int   D = 128, NW = 8, QBLK = 32, KVBLK = 64;
constexpr float SCALE = 0.088388347648318440f;
constexpr float THR = 8.f;
#ifndef ATT_SDEPTH
#define ATT_SDEPTH 1
#endif
constexpr int SDEPTH = ATT_SDEPTH;
constexpr int LDQ = 2048, LDK = 512, LDO = 2048;
constexpr int SHM_V = KVBLK * D * 2, SHM_K = KVBLK * D * 2, SHM_ATTN = 2 * SHM_V + 2 * SHM_K + NW * 64 * 4;
#define KSWZ(row, colB) ((row) * 256 + ((colB) ^ (((row) & 7) << 4)))
#define SBAR() __builtin_amdgcn_sched_barrier(0)
__device__ __forceinline__ int crow(int r, int hi) { return (r & 3) + 8 * (r >> 2) + 4 * hi; }
__device__ __forceinline__ unsigned cvtpk(float lo, float hi) { return pg8::cvt_pk_bf16(lo, hi); }

__device__ __forceinline__ void partialSM(f32x16& p0, f32x16& p1, float& m_reg, float& mn, float& alpha) {
  constexpr float C = SCALE * 1.4426950408889634f;
  float pmax = p0[0];
#pragma unroll
  for (int r = 1; r < 16; ++r) pmax = fmaxf(pmax, p0[r]);
#pragma unroll
  for (int r = 0; r < 16; ++r) pmax = fmaxf(pmax, p1[r]);
  { auto rr = __builtin_amdgcn_permlane32_swap(__float_as_uint(pmax), __float_as_uint(pmax), false, false);
    pmax = fmaxf(__uint_as_float(rr[0]), __uint_as_float(rr[1])); }
  if (__builtin_expect(__all(pmax - m_reg <= THR / SCALE), 1)) { mn = m_reg; alpha = 1.f; }
  else { mn = fmaxf(m_reg, pmax); alpha = __builtin_amdgcn_exp2f((m_reg - mn) * C); m_reg = mn; }
  float mnC = -mn * C;
#pragma unroll
  for (int r = 0; r < 16; ++r) p0[r] = fmaf(p0[r], C, mnC);
#pragma unroll
  for (int r = 0; r < 16; ++r) p1[r] = fmaf(p1[r], C, mnC);
#pragma unroll
  for (int r = 0; r < 16; ++r) p0[r] = __builtin_amdgcn_exp2f(p0[r]);
}
__device__ __forceinline__ void finishSM(f32x16& p0, f32x16& p1, float alpha, float& l_reg, bf16x8& pa0, bf16x8& pa1, bf16x8& pa2, bf16x8& pa3) {
#pragma unroll
  for (int r = 0; r < 16; ++r) p1[r] = __builtin_amdgcn_exp2f(p1[r]);
  float ps = 0;
#pragma unroll
  for (int r = 0; r < 16; ++r) ps += p0[r];
#pragma unroll
  for (int r = 0; r < 16; ++r) ps += p1[r];
  { auto rr = __builtin_amdgcn_permlane32_swap(__float_as_uint(ps), __float_as_uint(ps), false, false);
    ps = __uint_as_float(rr[0]) + __uint_as_float(rr[1]); }
  l_reg = l_reg * alpha + ps;
#define PK4(P, BASE, OUT) do { unsigned a0 = cvtpk(P[BASE + 0], P[BASE + 1]), a1 = cvtpk(P[BASE + 2], P[BASE + 3]);   \
    unsigned b0 = cvtpk(P[BASE + 4], P[BASE + 5]), b1 = cvtpk(P[BASE + 6], P[BASE + 7]);                              \
    auto r0 = __builtin_amdgcn_permlane32_swap(a0, b0, false, false); auto r1 = __builtin_amdgcn_permlane32_swap(a1, b1, false, false); \
    u32x4 w = {r0[0], r1[0], r0[1], r1[1]}; OUT = *reinterpret_cast<bf16x8*>(&w); } while (0)
  PK4(p0, 0, pa0); PK4(p0, 8, pa1); PK4(p1, 0, pa2); PK4(p1, 8, pa3);
#undef PK4
}
__device__ __forceinline__ void qkt(f32x16& p0, f32x16& p1, const ATT_LAS char* Ks, const bf16x8* qr, int r32, int hi) {
  p0 = f32x16{}; p1 = f32x16{};
#pragma unroll
  for (int d0 = 0; d0 < 8; ++d0) { const int cb = (d0 * 16 + hi * 8) * 2;
    const bf16x8 b0 = *reinterpret_cast<const ATT_LAS bf16x8*>(Ks + KSWZ(r32, cb));
    const bf16x8 b1 = *reinterpret_cast<const ATT_LAS bf16x8*>(Ks + KSWZ(32 + r32, cb));
    p0 = __builtin_amdgcn_mfma_f32_32x32x16_bf16(b0, qr[d0], p0, 0, 0, 0);
    p1 = __builtin_amdgcn_mfma_f32_32x32x16_bf16(b1, qr[d0], p1, 0, 0, 0); }
}
__device__ __forceinline__ int v_st(int k, int c) { const int kk = (k & ~0xC) | ((k & 4) << 1) | ((k & 8) >> 1); return ((kk >> 3) * 4 + (c >> 5)) * 512 + ((kk & 7) * 32 + (c & 31)) * 2; }
__device__ __forceinline__ int v_rd_base(int lane) { return ((lane & 3) << 3) | (((lane >> 2) & 3) << 6) | (((lane >> 4) & 1) << 5) | (((lane >> 5) & 1) << 8); }
constexpr int v_rd_off(int d0, int ks, int half) { return d0 * 512 + ks * 4096 + half * 2048; }
template <int OFF> __device__ __forceinline__ s16x4 tr_read(int vb) {
  s16x4 r; asm volatile("ds_read_b64_tr_b16 %0, %1 offset:%2" : "=&v"(r) : "v"(vb), "i"(OFF) : "memory"); return r;
}
template <int D0> __device__ __forceinline__ void pv_one(f32x16& od, int vb, bf16x8 pa0, bf16x8 pa1, bf16x8 pa2, bf16x8 pa3) {
  const s16x4 l0 = tr_read<v_rd_off(D0, 0, 0)>(vb), h0 = tr_read<v_rd_off(D0, 0, 1)>(vb), l1 = tr_read<v_rd_off(D0, 1, 0)>(vb), h1 = tr_read<v_rd_off(D0, 1, 1)>(vb);
  const s16x4 l2 = tr_read<v_rd_off(D0, 2, 0)>(vb), h2 = tr_read<v_rd_off(D0, 2, 1)>(vb), l3 = tr_read<v_rd_off(D0, 3, 0)>(vb), h3 = tr_read<v_rd_off(D0, 3, 1)>(vb);
  asm volatile("s_waitcnt lgkmcnt(0)" ::: "memory"); SBAR();
#define PK(L, H) (bf16x8){L[0], L[1], L[2], L[3], H[0], H[1], H[2], H[3]}
  od = __builtin_amdgcn_mfma_f32_32x32x16_bf16(pa0, PK(l0, h0), od, 0, 0, 0);
  od = __builtin_amdgcn_mfma_f32_32x32x16_bf16(pa1, PK(l1, h1), od, 0, 0, 0);
  od = __builtin_amdgcn_mfma_f32_32x32x16_bf16(pa2, PK(l2, h2), od, 0, 0, 0);
  od = __builtin_amdgcn_mfma_f32_32x32x16_bf16(pa3, PK(l3, h3), od, 0, 0, 0);
#undef PK
}
__device__ __forceinline__ void pv_d0(f32x16* o, int vb, bf16x8 pa0, bf16x8 pa1, bf16x8 pa2, bf16x8 pa3) {
  pv_one<0>(o[0], vb, pa0, pa1, pa2, pa3); pv_one<1>(o[1], vb, pa0, pa1, pa2, pa3); pv_one<2>(o[2], vb, pa0, pa1, pa2, pa3); pv_one<3>(o[3], vb, pa0, pa1, pa2, pa3);
}
constexpr float O8SCALE = 16.0f;
__device__ __forceinline__ void attn_unit(const bf16_t* __restrict__ Qb, const bf16_t* __restrict__ Kh, const bf16_t* __restrict__ Vh, unsigned char* __restrict__ Ob, int seq, ATT_LAS char* lds,
                                          const float* __restrict__ qg, const float* __restrict__ tab, int tpos0) {
  int tid_ = threadIdx.x; asm volatile("" : "+v"(tid_));
  const int tid = tid_, wid = tid >> 6, lane = tid & 63, r32 = lane & 31, hi = lane >> 5;
  ATT_LAS char* V_lds = lds; ATT_LAS char* K_lds = lds + 2 * SHM_V;
  ATT_LAS float* ws = (ATT_LAS float*)(lds + 2 * SHM_V + 2 * SHM_K) + wid * 64; ATT_LAS float* li_l = ws; ATT_LAS float* al_l = ws + 32;
  float m_reg = -1e30f, l_reg = 0; f32x16 o[4] = {}; bf16x8 qr[8];
  const bf16_t* Qw = Qb + (long)(wid * QBLK + r32) * LDQ + hi * 8;
#pragma unroll
  for (int d0 = 0; d0 < 8; ++d0) qr[d0] = *reinterpret_cast<const bf16x8*>(Qw + d0 * 16);
  {
    typedef float f32x4a __attribute__((ext_vector_type(4)));
    float x[8][8]; float ss = 0.f;
#pragma unroll
    for (int d0 = 0; d0 < 8; ++d0)
#pragma unroll
      for (int e = 0; e < 8; ++e) { x[d0][e] = __uint_as_float((unsigned)(unsigned short)qr[d0][e] << 16); ss += x[d0][e] * x[d0][e]; }
    { auto rr = __builtin_amdgcn_permlane32_swap(__float_as_uint(ss), __float_as_uint(ss), false, false); ss = __uint_as_float(rr[0]) + __uint_as_float(rr[1]); }
    const float inv = 1.0f / sqrtf(ss * (1.0f / 128.0f) + 1e-6f);
#pragma unroll
    for (int d0 = 0; d0 < 8; ++d0) { const f32x4a g0 = *reinterpret_cast<const f32x4a*>(qg + d0 * 16 + hi * 8), g1 = *reinterpret_cast<const f32x4a*>(qg + d0 * 16 + hi * 8 + 4);
#pragma unroll
      for (int e = 0; e < 4; ++e) { x[d0][e] = x[d0][e] * inv * g0[e]; x[d0][4 + e] = x[d0][4 + e] * inv * g1[e]; } }
    const int tq = tpos0 + wid * QBLK + r32;
#pragma unroll
    for (int ax = 0; ax < 2; ++ax) { const int pos = ax == 0 ? (tq >> 6) : (tq & 63);
#pragma unroll
      for (int h = 0; h < 2; ++h) { const f32x4a* tp = reinterpret_cast<const f32x4a*>(tab + (size_t)(pos * 32 + h * 16 + hi * 8) * 2);
#pragma unroll
        for (int e2 = 0; e2 < 4; ++e2) { const f32x4a cs = tp[e2];
#pragma unroll
          for (int k = 0; k < 2; ++k) { const int e = 2 * e2 + k; const float c = cs[2 * k], s = cs[2 * k + 1]; const float u0 = x[ax * 4 + h][e], u1 = x[ax * 4 + 2 + h][e];
            x[ax * 4 + h][e] = u0 * c - u1 * s; x[ax * 4 + 2 + h][e] = u1 * c + u0 * s; } } } }
#pragma unroll
    for (int d0 = 0; d0 < 8; ++d0) { u32x4 w = {cvtpk(x[d0][0], x[d0][1]), cvtpk(x[d0][2], x[d0][3]), cvtpk(x[d0][4], x[d0][5]), cvtpk(x[d0][6], x[d0][7])}; qr[d0] = *reinterpret_cast<bf16x8*>(&w); }
  }
  const int sr = tid >> 4, sc = (tid & 15) * 8, vst0 = v_st(sr, sc), vst1 = v_st(32 + sr, sc);
  const int vb0 = (int)(uintptr_t)V_lds + v_rd_base(lane);
  bf16x8 sv0[SDEPTH], sv1[SDEPTH], sk0[SDEPTH], sk1[SDEPTH];
#define SLOAD(i, k0) do { sv0[i] = *reinterpret_cast<const bf16x8*>(&Vh[(long)((k0) + sr) * LDK + sc]); sv1[i] = *reinterpret_cast<const bf16x8*>(&Vh[(long)((k0) + 32 + sr) * LDK + sc]); \
    sk0[i] = *reinterpret_cast<const bf16x8*>(&Kh[(long)((k0) + sr) * LDK + sc]); sk1[i] = *reinterpret_cast<const bf16x8*>(&Kh[(long)((k0) + 32 + sr) * LDK + sc]); } while (0)
#define SWRITE(b, i) do { *(ATT_LAS bf16x8*)(V_lds + (b) * SHM_V + vst0) = sv0[i]; *(ATT_LAS bf16x8*)(V_lds + (b) * SHM_V + vst1) = sv1[i]; const int kc = sc * 2; \
    *(ATT_LAS bf16x8*)(K_lds + (b) * SHM_K + KSWZ(sr, kc)) = sk0[i]; *(ATT_LAS bf16x8*)(K_lds + (b) * SHM_K + KSWZ(32 + sr, kc)) = sk1[i]; } while (0)
#define SWAIT() do { if constexpr (SDEPTH == 2) asm volatile("s_waitcnt vmcnt(4)" ::: "memory"); else asm volatile("s_waitcnt vmcnt(0)" ::: "memory"); } while (0)
#define RESC(a) do { if (__any((a) < 1.f)) { if (hi == 0) al_l[r32] = (a); asm volatile("s_waitcnt lgkmcnt(0)" ::: "memory"); \
    _Pragma("unroll") for (int d = 0; d < 4; ++d) _Pragma("unroll") for (int r = 0; r < 16; ++r) o[d][r] *= al_l[crow(r, hi)]; } } while (0)
  f32x16 pA0, pA1, pB0, pB1; float mnA, mnB, alA, alB; bf16x8 pa0, pa1, pa2, pa3; const int NT = seq / KVBLK;
  constexpr int SE = 0, SO = SDEPTH - 1;
  SLOAD(SE, 0); asm volatile("s_waitcnt vmcnt(0)" ::: "memory"); SWRITE(0, SE); __syncthreads();
  qkt(pA0, pA1, K_lds, qr, r32, hi); partialSM(pA0, pA1, m_reg, mnA, alA);
  SLOAD(SO, KVBLK); if constexpr (SDEPTH == 2) { if (2 < NT) SLOAD(SE, 2 * KVBLK); }
  SWAIT(); SWRITE(1, SO); __syncthreads();
  for (int j = 1; j + 1 < NT; j += 2) {
    SBAR(); qkt(pB0, pB1, K_lds + SHM_K, qr, r32, hi);
    finishSM(pA0, pA1, alA, l_reg, pa0, pa1, pa2, pa3); SBAR();
    SLOAD(SO, (j + SDEPTH) * KVBLK); SBAR();
    pv_d0(o, vb0, pa0, pa1, pa2, pa3); partialSM(pB0, pB1, m_reg, mnB, alB);
    __syncthreads(); SWAIT(); SWRITE(0, SE);
    RESC(alB); __syncthreads();
    SBAR(); qkt(pA0, pA1, K_lds, qr, r32, hi);
    finishSM(pB0, pB1, alB, l_reg, pa0, pa1, pa2, pa3); SBAR();
    if (SDEPTH == 1 || j + 3 < NT) SLOAD(SE, (j + 1 + SDEPTH) * KVBLK); SBAR();
    pv_d0(o, vb0 + SHM_V, pa0, pa1, pa2, pa3); partialSM(pA0, pA1, m_reg, mnA, alA);
    __syncthreads(); SWAIT(); SWRITE(1, SO);
    RESC(alA); __syncthreads();
  }
  SBAR(); qkt(pB0, pB1, K_lds + SHM_K, qr, r32, hi);
  finishSM(pA0, pA1, alA, l_reg, pa0, pa1, pa2, pa3); SBAR();
  pv_d0(o, vb0, pa0, pa1, pa2, pa3); partialSM(pB0, pB1, m_reg, mnB, alB);
  __syncthreads(); RESC(alB);
  finishSM(pB0, pB1, alB, l_reg, pa0, pa1, pa2, pa3); SBAR();
  pv_d0(o, vb0 + SHM_V, pa0, pa1, pa2, pa3);
  if (hi == 0) li_l[r32] = l_reg; asm volatile("s_waitcnt lgkmcnt(0)" ::: "memory");
  float rli[16];
#pragma unroll
  for (int r = 0; r < 16; ++r) rli[r] = __builtin_amdgcn_rcpf(li_l[crow(r, hi)]);
  unsigned char* Ow = Ob + (long)(wid * QBLK) * LDO;
#pragma unroll
  for (int r = 0; r < 16; ++r) { const int orow = crow(r, hi);
#pragma unroll
    for (int d0 = 0; d0 < 4; ++d0) { const float x = o[d0][r] * rli[r] * O8SCALE; Ow[(long)orow * LDO + d0 * 32 + r32] = (unsigned char)(__builtin_amdgcn_cvt_pk_fp8_f32(x, x, 0, false) & 0xff); } }
  __syncthreads();
#undef SLOAD
#undef SWRITE
#undef SWAIT
#undef RESC
}
constexpr float THR8 = 5.f;
constexpr int VT_STRIDE = 4 * 8192;
typedef int i32x8a __attribute__((ext_vector_type(8)));
typedef int i32x4a __attribute__((ext_vector_type(4)));
__device__ __forceinline__ unsigned pk4f8(float a, float b, float c, float d) { unsigned w = 0u; w = __builtin_amdgcn_cvt_pk_fp8_f32(a, b, w, false); w = __builtin_amdgcn_cvt_pk_fp8_f32(c, d, w, true); return w; }
__device__ __forceinline__ i32x8a ld32(const ATT_LAS char* p0, const ATT_LAS char* p1) { const i32x4a a = *reinterpret_cast<const ATT_LAS i32x4a*>(p0), b = *reinterpret_cast<const ATT_LAS i32x4a*>(p1); return __builtin_shufflevector(a, b, 0, 1, 2, 3, 4, 5, 6, 7); }
#define MFMA8(acc, a8, b8, one) asm volatile("v_mfma_scale_f32_32x32x64_f8f6f4 %0, %1, %2, %0, %3, %3 op_sel_hi:[0,0,0]" : "+v"(acc) : "v"(a8), "v"(b8), "v"(one))
__device__ __forceinline__ void partialSM8(f32x16& p0, f32x16& p1, float& m_reg, float& mn, float& alpha) {
  constexpr float C = SCALE * 1.4426950408889634f;
  float pmax = p0[0];
#pragma unroll
  for (int r = 1; r < 16; ++r) pmax = fmaxf(pmax, p0[r]);
#pragma unroll
  for (int r = 0; r < 16; ++r) pmax = fmaxf(pmax, p1[r]);
  { auto rr = __builtin_amdgcn_permlane32_swap(__float_as_uint(pmax), __float_as_uint(pmax), false, false);
    pmax = fmaxf(__uint_as_float(rr[0]), __uint_as_float(rr[1])); }
  if (__builtin_expect(__all(pmax - m_reg <= THR8 / SCALE), 1)) { mn = m_reg; alpha = 1.f; }
  else { mn = fmaxf(m_reg, pmax); alpha = __builtin_amdgcn_exp2f((m_reg - mn) * C); m_reg = mn; }
  float mnC = -mn * C;
#pragma unroll
  for (int r = 0; r < 16; ++r) p0[r] = fmaf(p0[r], C, mnC);
#pragma unroll
  for (int r = 0; r < 16; ++r) p1[r] = fmaf(p1[r], C, mnC);
#pragma unroll
  for (int r = 0; r < 16; ++r) p0[r] = __builtin_amdgcn_exp2f(p0[r]);
}
__device__ __forceinline__ void finishSM8(f32x16& p0, f32x16& p1, float alpha, float& l_reg, i32x8a& pa) {
#pragma unroll
  for (int r = 0; r < 16; ++r) p1[r] = __builtin_amdgcn_exp2f(p1[r]);
  float ps = 0;
#pragma unroll
  for (int r = 0; r < 16; ++r) ps += p0[r];
#pragma unroll
  for (int r = 0; r < 16; ++r) ps += p1[r];
  { auto rr = __builtin_amdgcn_permlane32_swap(__float_as_uint(ps), __float_as_uint(ps), false, false);
    ps = __uint_as_float(rr[0]) + __uint_as_float(rr[1]); }
  l_reg = l_reg * alpha + ps;
  pa = (i32x8a){(int)pk4f8(p0[0], p0[1], p0[2], p0[3]), (int)pk4f8(p0[4], p0[5], p0[6], p0[7]), (int)pk4f8(p0[8], p0[9], p0[10], p0[11]), (int)pk4f8(p0[12], p0[13], p0[14], p0[15]),
                (int)pk4f8(p1[0], p1[1], p1[2], p1[3]), (int)pk4f8(p1[4], p1[5], p1[6], p1[7]), (int)pk4f8(p1[8], p1[9], p1[10], p1[11]), (int)pk4f8(p1[12], p1[13], p1[14], p1[15])};
}
__device__ __forceinline__ int k8_off(int key, int c) { return key * 128 + ((c ^ ((key >> 1) & 7)) << 4); }
__device__ __forceinline__ int v8_off(int n, int c) { return n * 64 + ((c ^ ((n >> 2) & 3)) << 4); }
template <bool WAITSTATES>
__device__ __forceinline__ void qkt8(f32x16& p0, f32x16& p1, const ATT_LAS char* Ks, const i32x8a (&q8)[2], int r32, int hi, int one) {
  p0 = f32x16{}; p1 = f32x16{};
  const i32x8a k00 = ld32(Ks + k8_off(r32, 2 * hi), Ks + k8_off(r32, 2 * hi + 1)), k10 = ld32(Ks + k8_off(32 + r32, 2 * hi), Ks + k8_off(32 + r32, 2 * hi + 1));
  const i32x8a k01 = ld32(Ks + k8_off(r32, 4 + 2 * hi), Ks + k8_off(r32, 5 + 2 * hi)), k11 = ld32(Ks + k8_off(32 + r32, 4 + 2 * hi), Ks + k8_off(32 + r32, 5 + 2 * hi));
  asm volatile("s_nop 1" ::: "memory");
  __builtin_amdgcn_s_setprio(1); MFMA8(p0, k00, q8[0], one); MFMA8(p1, k10, q8[0], one); MFMA8(p0, k01, q8[1], one); MFMA8(p1, k11, q8[1], one); __builtin_amdgcn_s_setprio(0);
  if (WAITSTATES) asm volatile("s_nop 15\n\ts_nop 7" ::: "memory");
}
template <bool WAITSTATES>
__device__ __forceinline__ void pv8(f32x16* o, const ATT_LAS char* Vs, const i32x8a& pa, int r32, int hi, int one) {
  const i32x8a v0 = ld32(Vs + v8_off(r32, 2 * hi), Vs + v8_off(r32, 2 * hi + 1)), v1 = ld32(Vs + v8_off(32 + r32, 2 * hi), Vs + v8_off(32 + r32, 2 * hi + 1));
  const i32x8a v2 = ld32(Vs + v8_off(64 + r32, 2 * hi), Vs + v8_off(64 + r32, 2 * hi + 1)), v3 = ld32(Vs + v8_off(96 + r32, 2 * hi), Vs + v8_off(96 + r32, 2 * hi + 1));
  __builtin_amdgcn_s_setprio(1); MFMA8(o[0], pa, v0, one); MFMA8(o[1], pa, v1, one); MFMA8(o[2], pa, v2, one); MFMA8(o[3], pa, v3, one); __builtin_amdgcn_s_setprio(0);
  if (WAITSTATES) asm volatile("s_nop 15\n\ts_nop 7" ::: "memory");
}
__device__ __forceinline__ void attn_unit8(const bf16_t* __restrict__ Qb, const unsigned char* __restrict__ K8h, const unsigned char* __restrict__ VT8h, unsigned char* __restrict__ Ob, int seq, ATT_LAS char* lds,
                                           const float* __restrict__ qg, const float* __restrict__ tab, int tpos0) {
  int tid_ = threadIdx.x; asm volatile("" : "+v"(tid_));
  const int tid = tid_, wid = tid >> 6, lane = tid & 63, r32 = lane & 31, hi = lane >> 5;
  int one = 0x7f7f7f7f; asm volatile("" : "+v"(one));
  ATT_LAS char* V_lds = lds; ATT_LAS char* K_lds = lds + 3 * 8192;
  ATT_LAS float* ws = (ATT_LAS float*)(lds + 6 * 8192) + wid * 64; ATT_LAS float* li_l = ws; ATT_LAS float* al_l = ws + 32;
  float m_reg = -1e30f, l_reg = 0; f32x16 o[4] = {}; i32x8a q8[2];
  const int krow = tid >> 3, kch = tid & 7, kst = k8_off(krow, kch), vst = v8_off(tid >> 2, tid & 3);
  const unsigned char* kg = K8h + (long)krow * 512 + kch * 16; const unsigned char* vg = VT8h + tid * 16;
  i32x4a sk[2], sv[2];
#define SLOAD8(i, t) do { sk[i] = *reinterpret_cast<const i32x4a*>(kg + (long)(t) * (64 * 512)); sv[i] = *reinterpret_cast<const i32x4a*>(vg + (long)(t) * VT_STRIDE); } while (0)
#define SWRITE8(b, i) do { *reinterpret_cast<ATT_LAS i32x4a*>(K_lds + (b) * 8192 + kst) = sk[i]; *reinterpret_cast<ATT_LAS i32x4a*>(V_lds + (b) * 8192 + vst) = sv[i]; } while (0)
#define SWAIT8() asm volatile("s_waitcnt vmcnt(2)" ::: "memory")
#define SWRITE8R(boff, i) do { *reinterpret_cast<ATT_LAS i32x4a*>(K_lds + (boff) + kst) = sk[i]; *reinterpret_cast<ATT_LAS i32x4a*>(V_lds + (boff) + vst) = sv[i]; } while (0)
#define RESC8(a) do { if (__any((a) < 1.f)) { if (hi == 0) al_l[r32] = (a); asm volatile("s_waitcnt lgkmcnt(0)" ::: "memory"); \
    _Pragma("unroll") for (int d = 0; d < 4; ++d) _Pragma("unroll") for (int r = 0; r < 16; ++r) o[d][r] *= al_l[crow(r, hi)]; } } while (0)
  const int NT = seq / KVBLK;
  SLOAD8(0, 0);
  {
    typedef float f32x4a __attribute__((ext_vector_type(4)));
    const bf16_t* Qw = Qb + (long)(wid * QBLK + r32) * LDQ + hi * 8;
    bf16x8 qr[8];
#pragma unroll
    for (int d0 = 0; d0 < 8; ++d0) qr[d0] = *reinterpret_cast<const bf16x8*>(Qw + d0 * 16);
    float x[8][8]; float ss = 0.f;
#pragma unroll
    for (int d0 = 0; d0 < 8; ++d0)
#pragma unroll
      for (int e = 0; e < 8; ++e) { x[d0][e] = __uint_as_float((unsigned)(unsigned short)qr[d0][e] << 16); ss += x[d0][e] * x[d0][e]; }
    { auto rr = __builtin_amdgcn_permlane32_swap(__float_as_uint(ss), __float_as_uint(ss), false, false); ss = __uint_as_float(rr[0]) + __uint_as_float(rr[1]); }
    const float inv = 1.0f / sqrtf(ss * (1.0f / 128.0f) + 1e-6f);
#pragma unroll
    for (int d0 = 0; d0 < 8; ++d0) { const f32x4a g0 = *reinterpret_cast<const f32x4a*>(qg + d0 * 16 + hi * 8), g1 = *reinterpret_cast<const f32x4a*>(qg + d0 * 16 + hi * 8 + 4);
#pragma unroll
      for (int e = 0; e < 4; ++e) { x[d0][e] = x[d0][e] * inv * g0[e]; x[d0][4 + e] = x[d0][4 + e] * inv * g1[e]; } }
    const int tq = tpos0 + wid * QBLK + r32;
#pragma unroll
    for (int ax = 0; ax < 2; ++ax) { const int pos = ax == 0 ? (tq >> 6) : (tq & 63);
#pragma unroll
      for (int h = 0; h < 2; ++h) { const f32x4a* tp = reinterpret_cast<const f32x4a*>(tab + (size_t)(pos * 32 + h * 16 + hi * 8) * 2);
#pragma unroll
        for (int e2 = 0; e2 < 4; ++e2) { const f32x4a cs = tp[e2];
#pragma unroll
          for (int k = 0; k < 2; ++k) { const int e = 2 * e2 + k; const float c = cs[2 * k], s = cs[2 * k + 1]; const float u0 = x[ax * 4 + h][e], u1 = x[ax * 4 + 2 + h][e];
            x[ax * 4 + h][e] = u0 * c - u1 * s; x[ax * 4 + 2 + h][e] = u1 * c + u0 * s; } } } }
#pragma unroll
    for (int s = 0; s < 2; ++s)
      q8[s] = (i32x8a){(int)pk4f8(x[4 * s][0], x[4 * s][1], x[4 * s][2], x[4 * s][3]), (int)pk4f8(x[4 * s][4], x[4 * s][5], x[4 * s][6], x[4 * s][7]),
                       (int)pk4f8(x[4 * s + 1][0], x[4 * s + 1][1], x[4 * s + 1][2], x[4 * s + 1][3]), (int)pk4f8(x[4 * s + 1][4], x[4 * s + 1][5], x[4 * s + 1][6], x[4 * s + 1][7]),
                       (int)pk4f8(x[4 * s + 2][0], x[4 * s + 2][1], x[4 * s + 2][2], x[4 * s + 2][3]), (int)pk4f8(x[4 * s + 2][4], x[4 * s + 2][5], x[4 * s + 2][6], x[4 * s + 2][7]),
                       (int)pk4f8(x[4 * s + 3][0], x[4 * s + 3][1], x[4 * s + 3][2], x[4 * s + 3][3]), (int)pk4f8(x[4 * s + 3][4], x[4 * s + 3][5], x[4 * s + 3][6], x[4 * s + 3][7])};
  }
  f32x16 pA0, pA1, pB0, pB1; float mnA, mnB, alA, alB; i32x8a pa;
  asm volatile("s_waitcnt vmcnt(0)" ::: "memory"); SWRITE8(0, 0); __syncthreads();
  qkt8<true>(pA0, pA1, K_lds, q8, r32, hi, one); partialSM8(pA0, pA1, m_reg, mnA, alA);
  SLOAD8(1, 1); if (2 < NT) SLOAD8(0, 2);
  SWAIT8(); SWRITE8(1, 1); __syncthreads();
  int bK = 8192, bV = 0, bW = 2 * 8192;
  for (int j = 1; j + 1 < NT; j += 2) {
    SBAR(); qkt8<false>(pB0, pB1, K_lds + bK, q8, r32, hi, one);
    finishSM8(pA0, pA1, alA, l_reg, pa); SBAR();
    SLOAD8(1, j + 2); SBAR();
    pv8<false>(o, V_lds + bV, pa, r32, hi, one); partialSM8(pB0, pB1, m_reg, mnB, alB);
    SWAIT8(); SWRITE8R(bW, 0);
    RESC8(alB); __syncthreads();
    { const int t = bV; bV = bK; bK = bW; bW = t; }
    SBAR(); qkt8<false>(pA0, pA1, K_lds + bK, q8, r32, hi, one);
    finishSM8(pB0, pB1, alB, l_reg, pa); SBAR();
    if (j + 3 < NT) SLOAD8(0, j + 3); SBAR();
    pv8<false>(o, V_lds + bV, pa, r32, hi, one); partialSM8(pA0, pA1, m_reg, mnA, alA);
    SWAIT8(); SWRITE8R(bW, 1);
    RESC8(alA); __syncthreads();
    { const int t = bV; bV = bK; bK = bW; bW = t; }
  }
  SBAR(); qkt8<false>(pB0, pB1, K_lds + bK, q8, r32, hi, one);
  finishSM8(pA0, pA1, alA, l_reg, pa); SBAR();
  pv8<false>(o, V_lds + bV, pa, r32, hi, one); partialSM8(pB0, pB1, m_reg, mnB, alB);
  RESC8(alB);
  finishSM8(pB0, pB1, alB, l_reg, pa); SBAR();
  pv8<true>(o, V_lds + bK, pa, r32, hi, one);
  if (hi == 0) li_l[r32] = l_reg; asm volatile("s_waitcnt lgkmcnt(0)" ::: "memory");
  float rli[16];
#pragma unroll
  for (int r = 0; r < 16; ++r) rli[r] = __builtin_amdgcn_rcpf(li_l[crow(r, hi)]);
  unsigned char* Ow = Ob + (long)(wid * QBLK) * LDO;
  ATT_LAS unsigned char* ot = (ATT_LAS unsigned char*)lds + 65536 + wid * (32 * 144);
#pragma unroll
  for (int r = 0; r < 16; ++r) { const int orow = crow(r, hi);
#pragma unroll
    for (int d0 = 0; d0 < 4; ++d0) { const float xo = o[d0][r] * rli[r] * O8SCALE; ot[orow * 144 + d0 * 32 + r32] = (unsigned char)(__builtin_amdgcn_cvt_pk_fp8_f32(xo, xo, 0, false) & 0xff); } }
  asm volatile("s_waitcnt lgkmcnt(0)" ::: "memory");
#pragma unroll
  for (int k = 0; k < 4; ++k) { const int p = lane + 64 * k, row = p >> 3, c = p & 7;
    const i32x4a v = *reinterpret_cast<const ATT_LAS i32x4a*>(ot + row * 144 + c * 16);
    *reinterpret_cast<i32x4a*>(Ow + (long)row * LDO + c * 16) = v; }
  __syncthreads();
#undef SLOAD8
#undef SWRITE8
#undef SWAIT8
#undef RESC8
}
}

constexpr int NWAVES = 8;
constexpr int DM = 4096, T_P = 16384, T_ALL = 24576, SEQ_P = 2048, SEQ_S = 4096;
constexpr int NQ = 2048, NKV = 512, NU = 2048, INW = 13312, DFF = 11008, NUP = 22016;
constexpr float EPS = 1e-6f;
constexpr size_t MiB = 1u << 20;
constexpr size_t WS_CTL = 0, CTL_ZERO_BYTES = 1 * MiB;
constexpr size_t WS_ROPE = 1 * MiB;
constexpr size_t WS_WIN = 2 * MiB;
constexpr size_t WS_WDOWN = WS_WIN;
constexpr size_t WS_WATT = 106 * MiB;
constexpr size_t WS_WPOOL = 122 * MiB;
constexpr size_t WS_WOUT = 126 * MiB;
constexpr size_t WS_WUP = 158 * MiB;
constexpr size_t WS_R1 = 330 * MiB;
constexpr size_t WS_D = WS_R1, WS_O = WS_R1 + 96 * MiB;
constexpr size_t WS_Q = 522 * MiB, WS_K = 618 * MiB, WS_V = 642 * MiB, WS_U = 666 * MiB, WS_SA = 762 * MiB, WS_SP = 954 * MiB;
constexpr size_t WS_ACT = 522 * MiB;
constexpr size_t WS_HB = 1038 * MiB;
constexpr size_t WS_END = 1146 * MiB;
static_assert(WS_WIN + (size_t)INW * DM * 2 == WS_WATT && WS_WUP + (size_t)NUP * DM * 2 == WS_R1 && WS_R1 + (size_t)T_ALL * DM * 2 == WS_Q, "ws map");
static_assert(WS_SP + (size_t)T_ALL * DM * 2 == WS_END && WS_ACT + (size_t)T_ALL * DFF * 2 == WS_HB && WS_HB + (size_t)96 * 4 * NUP * 4 <= WS_END, "ws map 2");
static_assert(WS_WDOWN + (size_t)DM * DFF * 2 <= WS_WATT, "ws map 3");
constexpr size_t WS_WIN8 = WS_WIN + 16 * MiB;
constexpr size_t N8_OFF = (size_t)DM * DFF * 2;
constexpr int I_DOWN_TAIL = 10240;
constexpr size_t WS_K8 = WS_O + 48 * MiB;
constexpr size_t WS_VT8 = WS_O + 60 * MiB;
constexpr int CW_BAR = 4096;
constexpr size_t CTL_TAILF = 262144;
constexpr size_t CTL_SSQ1 = 65536;
constexpr int RING_OFF = 0, RING_BYTES = 131072;
constexpr int LDSCTL_OFF = RING_BYTES, MISC_OFF = LDSCTL_OFF + 320;
constexpr int LDS_BYTES = 147456;

#define GAS __attribute__((address_space(1)))
#define LAS __attribute__((address_space(3)))
typedef unsigned short bf16;
typedef unsigned v4u __attribute__((ext_vector_type(4)));
typedef unsigned v2u __attribute__((ext_vector_type(2)));
typedef float f32x4 __attribute__((ext_vector_type(4)));
typedef float f32x2 __attribute__((ext_vector_type(2)));
typedef GAS unsigned gu32;
#define RLX_AGENT __ATOMIC_RELAXED, __HIP_MEMORY_SCOPE_AGENT
#define LDS_WAIT() asm volatile("s_waitcnt lgkmcnt(0)" ::: "memory")
#define VM_WAIT() asm volatile("s_waitcnt vmcnt(0)" ::: "memory")
__device__ __forceinline__ unsigned pk2(float lo, float hi) { return pg8::cvt_pk_bf16(lo, hi); }
__device__ __forceinline__ float bflo(unsigned w) { return __uint_as_float(w << 16); }
__device__ __forceinline__ float bfhi(unsigned w) { return __uint_as_float(w & 0xffff0000u); }

#define XB_TMO      128
#define XB_XCNT(j)  (256  + 64 * (j))
#define XB_XSUB(j)  (1280 + 64 * (j))
#define XB_XGEN(j)  (2304 + 64 * (j))
#define XB_TOP      3328
#define XB_TOPGEN   3392
#define XCD_BAR_WORDS 3456
#define XB_SPIN_CAP (1u << 18)
__device__ __forceinline__ unsigned xb_ld(unsigned* p)              { return __hip_atomic_load(p, __ATOMIC_RELAXED, __HIP_MEMORY_SCOPE_AGENT); }
__device__ __forceinline__ unsigned xb_add(unsigned* p, unsigned v) { return __hip_atomic_fetch_add(p, v, __ATOMIC_RELAXED, __HIP_MEMORY_SCOPE_AGENT); }
__device__ __forceinline__ unsigned xb_xcc_id() { return (unsigned)__builtin_amdgcn_s_getreg((3 << 11) | 20) & 0xFu; }
#define XB_SPIN(cond, bar) do { unsigned _sp = 0; while (cond) { __builtin_amdgcn_s_sleep(1); \
    if ((++_sp & 255u) == 0u) { if (xb_ld(&(bar)[XB_TMO])) break; if (_sp > XB_SPIN_CAP) { atomicAdd(&(bar)[XB_TMO], 1u); break; } } } } while (0)

namespace pg8 {
struct EpiConvGluTail {
    static constexpr bool PERM = true, AFTER_DRAIN = false, USES_LDS = true, HALF_OK = false;
    EpiConvGlu inner; float* part; unsigned* flag; unsigned* bar; int kpart, slot;
    __device__ __forceinline__ void run(f32x4 (&acc)[2][2][4][2], const Unit& un, int wr, int wc, int fr, int fq, PG8_LAS unsigned char* xl) const {
        int t = wr * 256 + wc * 64 + fq * 16 + fr; asm volatile("" : "+v"(t));
        if (kpart != 0) {
            PG8_GAS f32x4* dst = (PG8_GAS f32x4*)(part + ((size_t)(slot * 3 + kpart - 1) << 16)) + t;
#pragma unroll
            for (int ai = 0; ai < 2; ++ai)
#pragma unroll
                for (int bj = 0; bj < 2; ++bj)
#pragma unroll
                    for (int m = 0; m < 4; ++m)
#pragma unroll
                        for (int n = 0; n < 2; ++n) dst[(((ai * 2 + bj) * 4 + m) * 2 + n) * 512] = acc[ai][bj][m][n];
            asm volatile("s_waitcnt vmcnt(0)" ::: "memory"); __builtin_amdgcn_s_barrier();
            if (t == 0) { __builtin_amdgcn_fence(__ATOMIC_RELEASE, "agent"); asm volatile("s_waitcnt vmcnt(0)" ::: "memory"); (void)xb_add(flag + slot * 16, 1u); }
        } else {
            if (t == 0) { XB_SPIN(xb_ld(flag + slot * 16) < 3u, bar); __builtin_amdgcn_fence(__ATOMIC_ACQUIRE, "agent"); }
            asm volatile("s_waitcnt vmcnt(0)" ::: "memory"); __builtin_amdgcn_s_barrier(); asm volatile("" ::: "memory");
#pragma unroll
            for (int p = 0; p < 3; ++p) {
                const PG8_GAS f32x4* src = (const PG8_GAS f32x4*)(part + ((size_t)(slot * 3 + p) << 16)) + t;
#pragma unroll
                for (int ai = 0; ai < 2; ++ai) {
                        f32x4 v[2][4][2];
#pragma unroll
                        for (int bj = 0; bj < 2; ++bj)
#pragma unroll
                        for (int m = 0; m < 4; ++m)
#pragma unroll
                            for (int n = 0; n < 2; ++n) v[bj][m][n] = src[(((ai * 2 + bj) * 4 + m) * 2 + n) * 512];
                        __builtin_amdgcn_sched_barrier(0);
#pragma unroll
                        for (int bj = 0; bj < 2; ++bj)
#pragma unroll
                        for (int m = 0; m < 4; ++m)
#pragma unroll
                            for (int n = 0; n < 2; ++n) { acc[ai][bj][m][n] += v[bj][m][n]; asm volatile("" : "+v"(acc[ai][bj][m][n])); }
                        __builtin_amdgcn_sched_barrier(0);
                    }
            }
            inner.run(acc, un, wr, wc, fr, fq, xl);
        }
    }
};
}

struct XcdBarrier {
    unsigned* bar; unsigned x;
    volatile LAS unsigned* st;
};

__device__ __forceinline__ XcdBarrier xcd_barrier_post(unsigned* bar, volatile LAS unsigned* st) {
    XcdBarrier b; b.bar = bar; b.x = xb_xcc_id(); b.st = st;
    if (threadIdx.x == 0) (void)xb_add(&bar[XB_XCNT(b.x)], 1u);
    return b;
}
__device__ __forceinline__ void xcd_barrier_complete(unsigned* bar, unsigned x, unsigned& nloc, unsigned& nx) {
    const unsigned G = gridDim.x * gridDim.y * gridDim.z;
    unsigned sum, cnt, mine, sp = 0u;
    for (;;) {
        sum = 0u; cnt = 0u; mine = 0u;
#pragma unroll
        for (unsigned j = 0; j < 16; ++j) { const unsigned c = xb_ld(&bar[XB_XCNT(j)]); sum += c; cnt += (c > 0u) ? 1u : 0u; mine = (j == x) ? c : mine; }
        if (sum == G) break;
        __builtin_amdgcn_s_sleep(1);
        if ((++sp & 255u) == 0u) { if (xb_ld(&bar[XB_TMO])) break; if (sp > XB_SPIN_CAP) { atomicAdd(&bar[XB_TMO], 1u); break; } }
    }
    nloc = mine > 0u ? mine : 1u; nx = cnt > 0u ? cnt : 1u;
}

__device__ __forceinline__ void xcd_barrier(const XcdBarrier& b) {
    asm volatile("s_waitcnt vmcnt(0)" ::: "memory");
    __syncthreads();
    if (threadIdx.x == 0) {
        unsigned* bar = b.bar;
        __builtin_amdgcn_s_waitcnt(0);
        unsigned nloc = b.st[0], nx = b.st[1];
        if (nloc == 0u) { xcd_barrier_complete(bar, b.x, nloc, nx); b.st[0] = nloc; b.st[1] = nx; }
        const unsigned old = xb_add(&bar[XB_XSUB(b.x)], 1u);
        const unsigned gen = old / nloc;
        if (old + 1u == (gen + 1u) * nloc) {
            __builtin_amdgcn_fence(__ATOMIC_RELEASE, "agent");
            asm volatile("s_waitcnt vmcnt(0)" ::: "memory");
            const unsigned og = xb_add(&bar[XB_TOP], 1u);
            const unsigned tg = og / nx;
            if (og + 1u == (tg + 1u) * nx) xb_add(&bar[XB_TOPGEN], 1u);
            else XB_SPIN(xb_ld(&bar[XB_TOPGEN]) == tg, bar);
            __builtin_amdgcn_fence(__ATOMIC_ACQUIRE, "agent");
            xb_add(&bar[XB_XGEN(b.x)], 1u);
            asm volatile("s_waitcnt vmcnt(0)" ::: "memory");
        } else {
            XB_SPIN(xb_ld(&bar[XB_XGEN(b.x)]) == gen, bar);
            __builtin_amdgcn_fence(__ATOMIC_ACQUIRE, "agent");
            asm volatile("s_waitcnt vmcnt(0)" ::: "memory");
        }
    }
    __syncthreads();
}

__device__ __forceinline__ float wave_sum(float v) {
#pragma unroll
    for (int o = 1; o < 64; o <<= 1) v += __shfl_xor(v, o);
    return v;
}
template <bool UPMAP = false>
__device__ __forceinline__ void transpose_item(const float* W, int K, int N, bf16* WT, int ldk, int row_off, LAS float* scr, int item, int lane, const float* kscale = nullptr) {
    const int nblk = N / 32, kb = item / nblk, nb = item % nblk, k0 = 64 * kb, n0 = 32 * nb;
    const int drow0 = UPMAP ? (n0 < DFF ? (n0 >> 7) * 256 + (n0 & 127) : ((n0 - DFF) >> 7) * 256 + 128 + ((n0 - DFF) & 127)) : row_off + n0;
    f32x4 wv[8]; const int kr = lane >> 3, nq = (lane & 7) * 4;
#pragma unroll
    for (int i = 0; i < 8; ++i) wv[i] = *(const GAS f32x4*)(W + (size_t)(k0 + 8 * i + kr) * N + n0 + nq);
#pragma unroll
    for (int i = 0; i < 8; ++i) { const int kk = 8 * i + kr; f32x4 w = wv[i]; if (kscale) w = w * kscale[k0 + kk];
        LAS float* d = scr + kk * 33 + nq; d[0] = w.x; d[1] = w.y; d[2] = w.z; d[3] = w.w; }
    LDS_WAIT(); asm volatile("" ::: "memory");
    const int c = lane & 7;
#pragma unroll
    for (int j = 0; j < 4; ++j) { const int n = (lane >> 3) + 8 * j; const LAS float* s = scr + (8 * c) * 33 + n;
        v4u o; o.x = pk2(s[0 * 33], s[1 * 33]); o.y = pk2(s[2 * 33], s[3 * 33]); o.z = pk2(s[4 * 33], s[5 * 33]); o.w = pk2(s[6 * 33], s[7 * 33]);
        *(GAS v4u*)(WT + (size_t)(drow0 + n) * ldk + k0 + 8 * c) = o; }
    LDS_WAIT(); asm volatile("" ::: "memory");
}
constexpr float W8SCALE = 64.0f;
__device__ __forceinline__ unsigned pk4_fp8(float a, float b, float c, float d) { unsigned w = 0u; w = __builtin_amdgcn_cvt_pk_fp8_f32(a, b, w, false); w = __builtin_amdgcn_cvt_pk_fp8_f32(c, d, w, true); return w; }
__device__ __forceinline__ void transpose_item_in(const float* W, bf16* WTu, unsigned char* WT8, LAS float* scr, int item, int lane) {
    constexpr int K = DM, N = INW;
    const int nblk = N / 32, kb = item / nblk, nb = item % nblk, k0 = 64 * kb, n0 = 32 * nb;
    f32x4 wv[8]; const int kr = lane >> 3, nq = (lane & 7) * 4;
#pragma unroll
    for (int i = 0; i < 8; ++i) wv[i] = *(const GAS f32x4*)(W + (size_t)(k0 + 8 * i + kr) * N + n0 + nq);
#pragma unroll
    for (int i = 0; i < 8; ++i) { const int kk = 8 * i + kr; const f32x4 w = wv[i]; LAS float* d = scr + kk * 33 + nq; d[0] = w.x; d[1] = w.y; d[2] = w.z; d[3] = w.w; }
    LDS_WAIT(); asm volatile("" ::: "memory");
    const int c = lane & 7;
    if (n0 >= 3072 && n0 < 5120) {
#pragma unroll
        for (int j = 0; j < 4; ++j) { const int n = (lane >> 3) + 8 * j; const LAS float* s = scr + (8 * c) * 33 + n;
            v4u o; o.x = pk2(s[0 * 33], s[1 * 33]); o.y = pk2(s[2 * 33], s[3 * 33]); o.z = pk2(s[4 * 33], s[5 * 33]); o.w = pk2(s[6 * 33], s[7 * 33]);
            *(GAS v4u*)(WTu + (size_t)(n0 - 3072 + n) * K + k0 + 8 * c) = o; }
    } else {
        const int r0 = n0 < 3072 ? n0 : n0 - 2048;
#pragma unroll
        for (int j = 0; j < 4; ++j) { const int n = (lane >> 3) + 8 * j; const LAS float* s = scr + (8 * c) * 33 + n;
            v2u o; o.x = pk4_fp8(s[0 * 33] * W8SCALE, s[1 * 33] * W8SCALE, s[2 * 33] * W8SCALE, s[3 * 33] * W8SCALE); o.y = pk4_fp8(s[4 * 33] * W8SCALE, s[5 * 33] * W8SCALE, s[6 * 33] * W8SCALE, s[7 * 33] * W8SCALE);
            *(GAS v2u*)(WT8 + (size_t)(r0 + n) * K + k0 + 8 * c) = o; }
    }
    LDS_WAIT(); asm volatile("" ::: "memory");
}
__device__ __forceinline__ void transpose_item_f8(const float* W, int K, int N, unsigned char* WT8, int ldk, LAS float* scr, int item, int lane) {
    const int nblk = N / 32, kb = item / nblk, nb = item % nblk, k0 = 64 * kb, n0 = 32 * nb;
    f32x4 wv[8]; const int kr = lane >> 3, nq = (lane & 7) * 4;
#pragma unroll
    for (int i = 0; i < 8; ++i) wv[i] = *(const GAS f32x4*)(W + (size_t)(k0 + 8 * i + kr) * N + n0 + nq);
#pragma unroll
    for (int i = 0; i < 8; ++i) { const int kk = 8 * i + kr; const f32x4 w = wv[i]; LAS float* d = scr + kk * 33 + nq; d[0] = w.x; d[1] = w.y; d[2] = w.z; d[3] = w.w; }
    LDS_WAIT(); asm volatile("" ::: "memory");
    const int c = lane & 7;
#pragma unroll
    for (int j = 0; j < 4; ++j) { const int n = (lane >> 3) + 8 * j; const LAS float* s = scr + (8 * c) * 33 + n;
        v2u o; o.x = pk4_fp8(s[0 * 33] * W8SCALE, s[1 * 33] * W8SCALE, s[2 * 33] * W8SCALE, s[3 * 33] * W8SCALE); o.y = pk4_fp8(s[4 * 33] * W8SCALE, s[5 * 33] * W8SCALE, s[6 * 33] * W8SCALE, s[7 * 33] * W8SCALE);
        *(GAS v2u*)(WT8 + (size_t)(n0 + n) * ldk + k0 + 8 * c) = o; }
    LDS_WAIT(); asm volatile("" ::: "memory");
}
__device__ __forceinline__ void rms_row_to_bf16(const float* xrow, const float* g, bf16* orow, int lane, unsigned char* o8row = nullptr) {
    const GAS f32x4* xr = (const GAS f32x4*)xrow + lane;
    f32x4 v[16]; float s = 0.f;
#pragma unroll
    for (int j = 0; j < 16; ++j) { v[j] = xr[64 * j]; s += (v[j].x * v[j].x + v[j].y * v[j].y) + (v[j].z * v[j].z + v[j].w * v[j].w); }
    const float inv = 1.0f / sqrtf(wave_sum(s) * (1.f / DM) + EPS);
    const GAS f32x4* gr = (const GAS f32x4*)g + lane;
    GAS v2u* o8 = (GAS v2u*)orow + lane;
#pragma unroll
    for (int j = 0; j < 16; ++j) { const f32x4 gg = gr[64 * j]; const float a = v[j].x * inv * gg.x, b = v[j].y * inv * gg.y, c = v[j].z * inv * gg.z, d = v[j].w * inv * gg.w;
        v2u w; w.x = pk2(a, b); w.y = pk2(c, d); o8[64 * j] = w;
        if (o8row) ((GAS unsigned*)o8row)[lane + 64 * j] = pk4_fp8(a, b, c, d); }
}
__device__ __forceinline__ void rms_row_bf16_to_f32(const bf16* hrow, const float* g, float* orow, int lane) {
    const GAS v4u* hr = (const GAS v4u*)hrow + lane;
    v4u v[8]; float s = 0.f;
#pragma unroll
    for (int j = 0; j < 8; ++j) { v[j] = hr[64 * j];
        const float a0 = bflo(v[j].x), a1 = bfhi(v[j].x), a2 = bflo(v[j].y), a3 = bfhi(v[j].y), a4 = bflo(v[j].z), a5 = bfhi(v[j].z), a6 = bflo(v[j].w), a7 = bfhi(v[j].w);
        s += ((a0 * a0 + a1 * a1) + (a2 * a2 + a3 * a3)) + ((a4 * a4 + a5 * a5) + (a6 * a6 + a7 * a7)); }
    const float inv = 1.0f / sqrtf(wave_sum(s) * (1.f / DM) + EPS);
#pragma unroll
    for (int j = 0; j < 8; ++j) { const int c = 512 * j + 8 * lane; const f32x4 g0 = *(const GAS f32x4*)(g + c), g1 = *(const GAS f32x4*)(g + c + 4);
        f32x4 o0, o1; o0.x = bflo(v[j].x) * inv * g0.x; o0.y = bfhi(v[j].x) * inv * g0.y; o0.z = bflo(v[j].y) * inv * g0.z; o0.w = bfhi(v[j].y) * inv * g0.w;
        o1.x = bflo(v[j].z) * inv * g1.x; o1.y = bfhi(v[j].z) * inv * g1.y; o1.z = bflo(v[j].w) * inv * g1.z; o1.w = bfhi(v[j].w) * inv * g1.w;
        *(GAS f32x4*)(orow + c) = o0; *(GAS f32x4*)(orow + c + 4) = o1; }
}
__device__ __forceinline__ void rms_row_inplace(float* xrow, const float* g, int lane) {
    GAS f32x4* xr = (GAS f32x4*)xrow + lane;
    f32x4 v[16]; float s = 0.f;
#pragma unroll
    for (int j = 0; j < 16; ++j) { v[j] = xr[64 * j]; s += (v[j].x * v[j].x + v[j].y * v[j].y) + (v[j].z * v[j].z + v[j].w * v[j].w); }
    const float inv = 1.0f / sqrtf(wave_sum(s) * (1.f / DM) + EPS);
    const GAS f32x4* gr = (const GAS f32x4*)g + lane;
#pragma unroll
    for (int j = 0; j < 16; ++j) { const f32x4 gg = gr[64 * j]; xr[64 * j] = v[j] * inv * gg; }
}
__device__ __forceinline__ void seq_pos(int m, int& t, int& S) { if (m < T_P) { t = m & (SEQ_P - 1); S = SEQ_P; } else { t = (m - T_P) & (SEQ_S - 1); S = SEQ_S; } }

template <int NB>
__device__ __forceinline__ void normrope_items(bf16* QB, bf16* KB, const float* qg, const float* kg, const f32x2* tab, int it0, int stride, int nitems, int lane, unsigned char* K8) {
    const int hh = lane >> 4, j = lane & 15, a = j >> 3, i0 = (j & 7) * 4;
    GAS v2u* p0[NB]; GAS v2u* p1[NB]; v2u w0[NB], w1[NB]; int tt[NB], mm[NB]; bool isq[NB], ok[NB];
#pragma unroll
    for (int b = 0; b < NB; ++b) { const int it = it0 + b * stride; ok[b] = it < nitems; const int itc = ok[b] ? it : it0; const int m = itc, s = 4; int t, S_; seq_pos(m, t, S_); tt[b] = t; mm[b] = m; isq[b] = s < 4;
        bf16* p4 = isq[b] ? QB + (size_t)m * NQ + s * 512 : KB + (size_t)m * NKV;
        p0[b] = (GAS v2u*)(p4 + hh * 128 + a * 64 + i0); p1[b] = (GAS v2u*)(p4 + hh * 128 + a * 64 + 32 + i0); w0[b] = *p0[b]; w1[b] = *p1[b]; }
#pragma unroll
    for (int b = 0; b < NB; ++b) {
        float x0[4] = {bflo(w0[b].x), bfhi(w0[b].x), bflo(w0[b].y), bfhi(w0[b].y)}, x1[4] = {bflo(w1[b].x), bfhi(w1[b].x), bflo(w1[b].y), bfhi(w1[b].y)};
        float ss = 0.f;
#pragma unroll
        for (int c = 0; c < 4; ++c) ss += x0[c] * x0[c] + x1[c] * x1[c];
        ss += __shfl_xor(ss, 1); ss += __shfl_xor(ss, 2); ss += __shfl_xor(ss, 4); ss += __shfl_xor(ss, 8);
        const float inv = 1.0f / sqrtf(ss * (1.f / 128.f) + EPS);
        const int pos = a == 0 ? (tt[b] >> 6) : (tt[b] & 63);
        const float* g = isq[b] ? qg : kg;
        const f32x4 g0 = *(const GAS f32x4*)(g + a * 64 + i0), g1 = *(const GAS f32x4*)(g + a * 64 + 32 + i0);
        float y0[4], y1[4];
#pragma unroll
        for (int c = 0; c < 4; ++c) { const f32x2 cs = tab[pos * 32 + i0 + c]; const float u0 = x0[c] * inv * g0[c], u1 = x1[c] * inv * g1[c]; y0[c] = u0 * cs.x - u1 * cs.y; y1[c] = u1 * cs.x + u0 * cs.y; }
        v2u o0, o1; o0.x = pk2(y0[0], y0[1]); o0.y = pk2(y0[2], y0[3]); o1.x = pk2(y1[0], y1[1]); o1.y = pk2(y1[2], y1[3]);
        if (ok[b]) {
            GAS unsigned char* kr = (GAS unsigned char*)K8 + (size_t)mm[b] * NKV + hh * 128 + a * 64 + ((i0 >> 3) & 1) * 32 + (i0 >> 4) * 8 + (i0 & 7);
            *(GAS unsigned*)kr = pk4_fp8(y0[0], y0[1], y0[2], y0[3]); *(GAS unsigned*)(kr + 16) = pk4_fp8(y1[0], y1[1], y1[2], y1[3]); }
    }
}
__device__ __forceinline__ void vt_block(const bf16* VB, unsigned char* VT8, int blk, int kvh, LAS unsigned char* scr, int lane) {
    const bf16* src = VB + (size_t)blk * 64 * NKV + kvh * 128;
    v4u x[16];
#pragma unroll
    for (int i = 0; i < 16; ++i) { const int ci = i * 64 + lane; x[i] = *(const GAS v4u*)(src + (size_t)(ci >> 4) * NKV + (ci & 15) * 8); }
#pragma unroll
    for (int i = 0; i < 16; ++i) { const int ci = i * 64 + lane, tok = ci >> 4, dch = ci & 15, s = tok >> 5, c = tok & 31, pos = ((c >> 2) & 1) * 32 + s * 16 + (c & 3) + 4 * (c >> 3);
        const unsigned w0 = __builtin_amdgcn_cvt_pk_fp8_f32(bflo(x[i].x), bfhi(x[i].x), 0, false), w1 = __builtin_amdgcn_cvt_pk_fp8_f32(bflo(x[i].y), bfhi(x[i].y), 0, false);
        const unsigned w2 = __builtin_amdgcn_cvt_pk_fp8_f32(bflo(x[i].z), bfhi(x[i].z), 0, false), w3 = __builtin_amdgcn_cvt_pk_fp8_f32(bflo(x[i].w), bfhi(x[i].w), 0, false);
        LAS unsigned char* d = scr + (dch * 8) * 64 + pos;
        d[0 * 64] = (unsigned char)w0; d[1 * 64] = (unsigned char)(w0 >> 8); d[2 * 64] = (unsigned char)w1; d[3 * 64] = (unsigned char)(w1 >> 8);
        d[4 * 64] = (unsigned char)w2; d[5 * 64] = (unsigned char)(w2 >> 8); d[6 * 64] = (unsigned char)w3; d[7 * 64] = (unsigned char)(w3 >> 8); }
    LDS_WAIT(); asm volatile("" ::: "memory");
    unsigned char* dst = VT8 + (size_t)(blk * 4 + kvh) * 8192;
#pragma unroll
    for (int i = 0; i < 8; ++i) *(GAS v4u*)(dst + (i * 64 + lane) * 16) = *(const LAS v4u*)(scr + (i * 64 + lane) * 16);
    LDS_WAIT(); asm volatile("" ::: "memory");
}
constexpr int PSEG = 32;
template <int W>
__device__ __forceinline__ void pool_seg(const bf16* u, bf16* d, int m0  , int grp, int lane) {
    int t0, S; seq_pos(m0, t0, S);
    const bf16* base = u + (size_t)(m0 - t0) * NU + grp * 512 + lane * 8;
    bf16* dbase = d + (size_t)(m0 - t0) * NU + grp * 512 + lane * 8;
    v4u ring[W]; float sum[8] = {0.f, 0.f, 0.f, 0.f, 0.f, 0.f, 0.f, 0.f};
    const v4u z = {0u, 0u, 0u, 0u};
#define POOL_ADD(vv_, sgn) do { const v4u q_ = (vv_); sum[0] += sgn bflo(q_.x); sum[1] += sgn bfhi(q_.x); sum[2] += sgn bflo(q_.y); sum[3] += sgn bfhi(q_.y); sum[4] += sgn bflo(q_.z); sum[5] += sgn bfhi(q_.z); sum[6] += sgn bflo(q_.w); sum[7] += sgn bfhi(q_.w); } while (0)
#pragma unroll
    for (int i = 0; i < W - 1; ++i) { const int r = t0 - W / 2 + i; const v4u x = (r >= 0 && r < S) ? *(const GAS v4u*)(base + (size_t)r * NU) : z; ring[(W - W / 2 + i) % W] = x; }
#pragma unroll
    for (int i = 0; i < W - 1; ++i) POOL_ADD(ring[(W - W / 2 + i) % W], +);
    ring[(W / 2 - 1) % W] = z;
#pragma unroll 1
    for (int b = 0; b < PSEG; b += 16) {
        v4u nw[16];
#pragma unroll
        for (int s = 0; s < 16; ++s) { const int r = t0 + b + s + W / 2 - 1; nw[s] = (r >= 0 && r < S) ? *(const GAS v4u*)(base + (size_t)r * NU) : z; }
#pragma unroll
        for (int s = 0; s < 16; ++s) { const int t = t0 + b + s;
            const int slot = (s + W / 2 - 1) % W;
            POOL_ADD(ring[slot], -); ring[slot] = nw[s]; POOL_ADD(nw[s], +);
            const int lo = t - W / 2 < 0 ? 0 : t - W / 2, hi = t + W / 2 > S ? S : t + W / 2; const float rc = 1.0f / (float)(hi - lo);
            const v4u c = ring[s % W];
            v4u o; o.x = pk2(sum[0] * rc - bflo(c.x), sum[1] * rc - bfhi(c.x)); o.y = pk2(sum[2] * rc - bflo(c.y), sum[3] * rc - bfhi(c.y));
            o.z = pk2(sum[4] * rc - bflo(c.z), sum[5] * rc - bfhi(c.z)); o.w = pk2(sum[6] * rc - bflo(c.w), sum[7] * rc - bfhi(c.w));
            *(GAS v4u*)(dbase + (size_t)t * NU) = o; }
    }
#undef POOL_ADD
}
__device__ __forceinline__ float silu_f(float x) { return x * __builtin_amdgcn_rcpf(1.0f + __builtin_amdgcn_exp2f(-1.4426950408889634f * x)); }
__device__ __forceinline__ void fixup_item(const float* hb, bf16* act, const float* cw, const float* cb, int pm, int which, int colg, int lane) {
    const int j0 = colg * 512 + lane * 8;
    if (j0 >= DFF) return;
    const int row = pm * 256 + (which ? 255 : 0); int t, S; seq_pos(row, t, S);
    const size_t tc = (size_t)(j0 >> 7) * 256 + (j0 & 127);
    const float* hp = which ? hb + ((size_t)pm * 4 + 2) * NUP : (t > 0 ? hb + ((size_t)(pm - 1) * 4 + 3) * NUP : nullptr);
    const float* hc = hb + ((size_t)pm * 4 + (which ? 3 : 0)) * NUP;
    const float* hn = which ? (t < S - 1 ? hb + ((size_t)(pm + 1) * 4 + 0) * NUP : nullptr) : hb + ((size_t)pm * 4 + 1) * NUP;
    float o[8];
#pragma unroll
    for (int q = 0; q < 2; ++q) {
        const int j = j0 + 4 * q; const size_t p = tc + 4 * q; const f32x4 z = {0.f, 0.f, 0.f, 0.f};
        const f32x4 gp = hp ? *(const GAS f32x4*)(hp + p) : z, vp = hp ? *(const GAS f32x4*)(hp + p + 128) : z;
        const f32x4 gc = *(const GAS f32x4*)(hc + p), vc = *(const GAS f32x4*)(hc + p + 128);
        const f32x4 gn = hn ? *(const GAS f32x4*)(hn + p) : z, vn = hn ? *(const GAS f32x4*)(hn + p + 128) : z;
        const f32x4 w0g = *(const GAS f32x4*)(cw + j), w1g = *(const GAS f32x4*)(cw + NUP + j), w2g = *(const GAS f32x4*)(cw + 2 * (size_t)NUP + j), bg = *(const GAS f32x4*)(cb + j);
        const f32x4 w0v = *(const GAS f32x4*)(cw + DFF + j), w1v = *(const GAS f32x4*)(cw + NUP + DFF + j), w2v = *(const GAS f32x4*)(cw + 2 * (size_t)NUP + DFF + j), bv = *(const GAS f32x4*)(cb + DFF + j);
#pragma unroll
        for (int e = 0; e < 4; ++e) { const float cg = bg[e] + w0g[e] * gp[e] + w1g[e] * gc[e] + w2g[e] * gn[e], cv = bv[e] + w0v[e] * vp[e] + w1v[e] * vc[e] + w2v[e] * vn[e]; o[4 * q + e] = silu_f(cg) * cv; }
    }
    v4u w; w.x = pk2(o[0], o[1]); w.y = pk2(o[2], o[3]); w.z = pk2(o[4], o[5]); w.w = pk2(o[6], o[7]);
    *(GAS v4u*)(act + (size_t)row * DFF + j0) = w;
}

struct Args { const float* in[16]; float* out; unsigned char* ws; };
template <int OFF> __device__ __forceinline__ unsigned long long karg_u64() {
    auto kp = __builtin_amdgcn_kernarg_segment_ptr(); unsigned long long v;
    asm volatile("s_load_dwordx2 %0, %1, %2\n\ts_waitcnt lgkmcnt(0)" : "=s"(v) : "s"(kp), "i"(OFF) : "memory"); return v;
}
#define KIN(i) ((const float*)karg_u64<8 * (i)>())
#define KOUT() ((float*)karg_u64<128>())
#define KWS() ((unsigned char*)karg_u64<136>())
__global__ void __launch_bounds__(NWAVES * 64, 2) fwd_kernel(Args args) {
    extern __shared__ __attribute__((aligned(16))) unsigned char lds[];
    LAS unsigned char* L = (LAS unsigned char*)lds;
    const int G = gridDim.x, bx = blockIdx.x;
    for (int u = threadIdx.x; u < (LDS_BYTES - LDSCTL_OFF) / 4; u += NWAVES * 64) ((LAS unsigned*)(L + LDSCTL_OFF))[u] = 0u;
    __syncthreads();
    XcdBarrier bar = xcd_barrier_post((unsigned*)(KWS() + WS_CTL) + CW_BAR, (volatile LAS unsigned*)(L + MISC_OFF) + 8);
#define GRID_BAR() xcd_barrier(bar)
#ifndef PH_MASK
#define PH_MASK 0xFFFF
#endif
#define PH(k) constexpr ((PH_MASK >> (k)) & 1)
#define TVIEW() int tid = threadIdx.x; asm volatile("" : "+v"(tid)); const int lane = tid & 63, wave = __builtin_amdgcn_readfirstlane(tid >> 6); \
    const int vcu = (G % 8 == 0) ? (bx % 8) * (G / 8) + bx / 8 : bx, gw = vcu * NWAVES + wave, NGW = G * NWAVES; (void)lane; (void)gw; (void)NGW; \
    unsigned char* ws = KWS(); (void)ws

    if PH(0)
    {
        TVIEW();
        LAS float* scr = (LAS float*)(L + RING_OFF + wave * 16384);
        constexpr int I_IN = (DM / 64) * (INW / 32), I_ATT = (NQ / 64) * (DM / 32), I_POOL = (512 / 64) * (1024 / 32), I_OUT = (DM / 64) * (DM / 32), I_UP = (DM / 64) * (NUP / 32);
        constexpr int I_DOWN = (DFF / 64) * (DM / 32), I_DOWN_P0 = I_DOWN - I_DOWN_TAIL;
        constexpr int NITEMS = I_IN + I_ATT + 4 * I_POOL + I_OUT + I_UP + I_DOWN_P0;
        for (int it = gw; it < NITEMS; it += NGW) {
            int r = it;
            if (r < I_IN) { transpose_item_in(KIN(3), (bf16*)(ws + WS_WIN), ws + WS_WIN8, scr, r, lane); continue; } r -= I_IN;
            if (r < I_ATT) { transpose_item_f8(KIN(6), NQ, DM, ws + WS_WATT, NQ, scr, r, lane); continue; } r -= I_ATT;
            if (r < 4 * I_POOL) { const int g = r / I_POOL; transpose_item(KIN(7) + (size_t)g * 512 * 1024, 512, 1024, (bf16*)(ws + WS_WPOOL), 512, g * 1024, scr, r % I_POOL, lane); continue; } r -= 4 * I_POOL;
            if (r < I_OUT) { transpose_item(KIN(9), DM, DM, (bf16*)(ws + WS_WOUT), DM, 0, scr, r, lane); continue; } r -= I_OUT;
            if (r < I_UP) { transpose_item<true>(KIN(11), DM, NUP, (bf16*)(ws + WS_WUP), DM, 0, scr, r, lane, KIN(10)); continue; } r -= I_UP;
            transpose_item(KIN(14), DFF, DM, (bf16*)KOUT(), DFF, 0, scr, I_DOWN_TAIL + r, lane);
        }
        f32x2* rope = (f32x2*)(ws + WS_ROPE);
        for (int e = bx * (NWAVES * 64) + tid; e < 64 * 32; e += G * NWAVES * 64) {
            const int pos = e >> 5, i = e & 31; const float inv_freq = exp2f(-(float)i * (13.287712379549449f / 32.0f)); const float ang = (float)pos * inv_freq;
            f32x2 cs; cs.x = cosf(ang); cs.y = sinf(ang); rope[e] = cs; }
        const float* xp = KIN(0); const float* xs = KIN(1); const float* g_mix = KIN(2); bf16* NB = (bf16*)(ws + WS_R1);
        for (int m = gw; m < T_ALL; m += NGW) rms_row_to_bf16(m < T_P ? xp + (size_t)m * DM : xs + (size_t)(m - T_P) * DM, g_mix, NB + (size_t)m * DM, lane, (unsigned char*)KOUT() + N8_OFF + (size_t)m * DM);
    }
    GRID_BAR();
    if PH(1)
    {
        unsigned char* ws = KWS();
        {
            pg8::Gemm g{(bf16*)(ws + WS_R1), (bf16*)(ws + WS_WIN), DM, DM, DM, 0, 0u}; pg8::StaticOrder S; S.init(T_ALL, NU, G, bx);
            pg8::EpiBf16 E{(bf16*)(ws + WS_U), NU};
            pg8::gemm_phase<pg8::EpiBf16, pg8::StaticOrder, true, true>(L + RING_OFF, g, S, E);
        }
        {
            pg8::Gemm g{(bf16*)((unsigned char*)KOUT() + N8_OFF), (bf16*)(ws + WS_WIN8), DM / 2, DM / 2, DM / 2, 0, 0u}; pg8::StaticOrder S; S.init(T_ALL, INW - NU, G, bx);
            pg8::EpiProj8 E{(bf16*)(ws + WS_Q), (bf16*)(ws + WS_K), (bf16*)(ws + WS_V), (bf16*)(ws + WS_SA), (bf16*)(ws + WS_SP), 1.0f / W8SCALE};
            pg8::gemm_phase<pg8::EpiProj8, pg8::StaticOrder, true, true, true>(L + RING_OFF, g, S, E);
        }
        { constexpr int NWG = (T_ALL / 256) * ((INW - NU) / 256), I_DOWN = (DFF / 64) * (DM / 32);
          const int rem = NWG % G, nh = rem ? G - rem : G, hidx = rem ? bx - rem : bx;
          if (hidx >= 0) { TVIEW(); LAS float* scr = (LAS float*)(L + RING_OFF + wave * 16384); const float* w_down = KIN(14); bf16* WD = (bf16*)KOUT();
              for (int it = hidx * NWAVES + wave; it < I_DOWN_TAIL; it += nh * NWAVES) transpose_item(w_down, DFF, DM, WD, DFF, 0, scr, it, lane); } }
    }
    GRID_BAR();
    if PH(2)
    {
        TVIEW();
        LAS float* scr = (LAS float*)(L + RING_OFF + wave * 16384);
        { const float* qg = KIN(4); const float* kg = KIN(5); const f32x2* rope = (const f32x2*)(ws + WS_ROPE); bf16* QB = (bf16*)(ws + WS_Q); bf16* KB = (bf16*)(ws + WS_K);
          for (int it = gw; it < T_ALL; it += 4 * NGW) normrope_items<4>(QB, KB, qg, kg, rope, it, NGW, T_ALL, lane, ws + WS_K8); }
        { const bf16* VB = (const bf16*)(ws + WS_V); LAS unsigned char* scr8 = L + RING_OFF + wave * 16384;
          for (int it = gw; it < (T_ALL / 64) * 4; it += NGW) vt_block(VB, ws + WS_VT8, it >> 2, it & 3, scr8, lane); }
        { const bf16* UB = (const bf16*)(ws + WS_U); bf16* DB = (bf16*)(ws + WS_D);
          for (int it = gw; it < (T_ALL / PSEG) * 4; it += NGW) { const int m0 = (it >> 2) * PSEG, gr = it & 3;
              if (gr == 0) pool_seg<2>(UB, DB, m0, 0, lane); else if (gr == 1) pool_seg<4>(UB, DB, m0, 1, lane); else if (gr == 2) pool_seg<8>(UB, DB, m0, 2, lane); else pool_seg<16>(UB, DB, m0, 3, lane); } }
    }
    GRID_BAR();
    if PH(3)
    {
        unsigned char* ws = KWS();
        const bf16* QB = (const bf16*)(ws + WS_Q); const bf16* KB = (const bf16*)(ws + WS_K); const bf16* VB = (const bf16*)(ws + WS_V); unsigned char* OB = ws + WS_O;
        const float* qg = KIN(4); const float* rope = (const float*)(ws + WS_ROPE);
        for (int s = bx; s < 6 * 256; s += G) {
            const int r = s >> 8, c = s & 255, xcd = c & 7, idx = c >> 3;
            int b, kvh, h, qb, S_, row0;
            if (r < 4) { const int grp = 4 * xcd + r; b = grp >> 2; kvh = grp & 3; h = kvh * 4 + (idx >> 3); qb = idx & 7; S_ = SEQ_P; row0 = b * SEQ_P; }
            else { b = xcd >> 2; kvh = xcd & 3; const int un = idx + 32 * (r - 4); h = kvh * 4 + (un >> 4); qb = un & 15; S_ = SEQ_S; row0 = T_P + b * SEQ_S; }
            att::attn_unit8(QB + (size_t)(row0 + qb * 256) * NQ + h * 128, ws + WS_K8 + (size_t)row0 * NKV + kvh * 128, ws + WS_VT8 + (size_t)((row0 >> 6) * 4 + kvh) * 8192,
                            OB + (size_t)(row0 + qb * 256) * NQ + h * 128, S_, (LAS char*)(L + RING_OFF), qg, rope, qb * 256);
        }
    }
    GRID_BAR();
    if PH(4)
    {
        unsigned char* ws = KWS();
        pg8::Gemm g{(bf16*)(ws + WS_D), (bf16*)(ws + WS_WPOOL), NU, 512, 512, 2, 1024u}; pg8::StaticOrder S; S.init(T_ALL, DM, G, bx);
        pg8::EpiPool E{(bf16*)(ws + WS_SP), KIN(8)};
        pg8::gemm_phase<pg8::EpiPool, pg8::StaticOrder, false, true>(L + RING_OFF, g, S, E);
    }
    if PH(5)
    {
        unsigned char* ws = KWS();
        pg8::Gemm g{(bf16*)(ws + WS_O), (bf16*)(ws + WS_WATT), NQ / 2, NQ / 2, NQ / 2, 0, 0u}; pg8::StaticOrder S; S.init(T_ALL, DM, G, bx);
        pg8::EpiMerge E{(bf16*)(ws + WS_SA), (const bf16*)(ws + WS_SP), 1.0f / (W8SCALE * att::O8SCALE)};
        pg8::gemm_phase<pg8::EpiMerge, pg8::StaticOrder, false, true, true>(L + RING_OFF, g, S, E);
    }
    GRID_BAR();
    if PH(6)
    {
        unsigned char* ws = KWS();
        pg8::Gemm g{(bf16*)(ws + WS_SA), (bf16*)(ws + WS_WOUT), DM, DM, DM, 0, 0u}; pg8::StaticOrder S; S.init(T_ALL, DM, G, bx);
        pg8::EpiResNorm E{KIN(0), KIN(1), T_P / 256, (bf16*)(ws + WS_R1), (float*)(ws + WS_CTL + CTL_SSQ1)};
        pg8::gemm_phase<pg8::EpiResNorm, pg8::StaticOrder, false, true>(L + RING_OFF, g, S, E);
    }
    GRID_BAR();
    if PH(8)
    {
        unsigned char* ws = KWS();
        pg8::Gemm g{(bf16*)(ws + WS_R1), (bf16*)(ws + WS_WUP), DM, DM, DM, 0, 0u}; pg8::StaticOrder S; S.init(T_ALL, NUP, G, bx);
        pg8::EpiConvGlu E{(bf16*)(ws + WS_ACT), (float*)(ws + WS_HB), KIN(12), KIN(13), DFF, NUP, (const float*)(ws + WS_CTL + CTL_SSQ1), 1.0f / DM, EPS};
        S.lim = (S.nwg / G) * G;
        pg8::gemm_phase<pg8::EpiConvGlu, pg8::StaticOrder, true, true>(L + RING_OFF, g, S, E);
        if (G == 256 && S.nwg - S.lim == 64) {
            const int j = bx >> 3, kp = j & 3, slot = (j >> 2) * 8 + (bx & 7);
            pg8::Gemm g2{(bf16*)(ws + WS_R1) + kp * (DM / 4), (bf16*)(ws + WS_WUP) + kp * (DM / 4), DM, DM, DM / 4, 0, 0u};
            pg8::StaticOrder S2; S2.init(T_ALL, NUP, S.nwg, S.lim + slot);
            pg8::EpiConvGluTail E2{E, (float*)(ws + WS_WIN), (unsigned*)(ws + WS_CTL + CTL_TAILF), bar.bar, kp, slot};
            pg8::gemm_phase<pg8::EpiConvGluTail, pg8::StaticOrder, true, true>(L + RING_OFF, g2, S2, E2);
        } else {
            pg8::StaticOrder S2; S2.init(T_ALL, NUP, S.nwg, S.lim + bx); if (bx >= S.nwg - S.lim) S2.lim = 0;
            pg8::gemm_phase<pg8::EpiConvGlu, pg8::StaticOrder, true, true>(L + RING_OFF, g, S2, E);
        }
    }
    GRID_BAR();
    if PH(8)
    {
        TVIEW();
        const float* HB = (const float*)(ws + WS_HB); bf16* ACT = (bf16*)(ws + WS_ACT); const float* conv_w = KIN(12); const float* conv_b = KIN(13);
        for (int it = gw; it < 96 * 2 * 22; it += NGW) fixup_item(HB, ACT, conv_w, conv_b, it / 44, (it % 44) / 22, it % 22, lane);
    }
    GRID_BAR();
    if PH(8)
    {
        unsigned char* ws = KWS();
        pg8::Gemm g{(bf16*)(ws + WS_ACT), (bf16*)KOUT(), DFF, DFF, DFF, 0, 0u}; pg8::StaticOrder S; S.init(T_ALL, DM, G, bx);
        pg8::EpiResBf16 E{(bf16*)(ws + WS_R1)};
        pg8::gemm_phase<pg8::EpiResBf16, pg8::StaticOrder, false, true>(L + RING_OFF, g, S, E);
    }
    GRID_BAR();
    if PH(9)
    {
        TVIEW();
        float* out = KOUT(); const float* g_fin = KIN(15);
        const bf16* H2 = (const bf16*)(ws + WS_R1);
        for (int m = gw; m < T_ALL; m += NGW) rms_row_bf16_to_f32(H2 + (size_t)m * DM, g_fin, out + (size_t)m * DM, lane);
    }
}

extern "C" void kernel_launch(void* const* d_in, const int* in_sizes, int n_in, void* d_out, int out_size, void* d_ws, size_t ws_size, hipStream_t stream) {
    static int grid = 0;
    if (grid == 0) {
        if (n_in != 16 || out_size != T_ALL * DM || ws_size < WS_END) { fprintf(stderr, "kernel_launch: unexpected shapes (n_in %d out %d ws %zu need %zu); nothing launched\n", n_in, out_size, ws_size, (size_t)WS_END); grid = -1; return; }
        int dev = 0, cus = 0, per_cu = 0;
        if (hipGetDevice(&dev) != hipSuccess || hipDeviceGetAttribute(&cus, hipDeviceAttributeMultiprocessorCount, dev) != hipSuccess) { grid = -1; return; }
        if (hipFuncSetAttribute((const void*)fwd_kernel, hipFuncAttributeMaxDynamicSharedMemorySize, LDS_BYTES) != hipSuccess) { fprintf(stderr, "kernel_launch: hipFuncSetAttribute failed\n"); grid = -1; return; }
        if (hipOccupancyMaxActiveBlocksPerMultiprocessor(&per_cu, (const void*)fwd_kernel, NWAVES * 64, LDS_BYTES) != hipSuccess || per_cu < 1) { fprintf(stderr, "kernel_launch: occupancy query reports %d\n", per_cu); }
        (void)hipGetLastError();
        grid = cus;
    }
    if (grid < 0) return;
    if (hipMemsetAsync((char*)d_ws + WS_CTL, 0, CTL_ZERO_BYTES, stream) != hipSuccess) return;
    Args a{};
    for (int i = 0; i < 16; ++i) a.in[i] = (const float*)d_in[i];
    a.out = (float*)d_out; a.ws = (unsigned char*)d_ws;
    hipLaunchKernelGGL(fwd_kernel, dim3(grid), dim3(NWAVES * 64), LDS_BYTES, stream, a);
}
```

```cpp
#include <hip/hip_runtime.h>
#include <cstdio>
#include <cstdint>
namespace pg8 {
#define PG8_LAS __attribute__((address_space(3)))
#define PG8_GAS __attribute__((address_space(1)))
typedef unsigned short bf16_t;
typedef short bf16x8 __attribute__((ext_vector_type(8)));
typedef float f32x4 __attribute__((ext_vector_type(4)));
typedef unsigned u32x4 __attribute__((ext_vector_type(4)));
constexpr int BM = 256, BK = 64, HALF = 128, HTB = HALF * BK * 2  , STAGE_BYTES = 8 * HTB, NXCD = 8, WGM = 4;
constexpr int XL_OFF = STAGE_BYTES + 1024;

__host__ __device__ __forceinline__ int lds_byte(int r, int c) { const int st = (r >> 4) * 2 + (c >> 5), rr = r & 15, cc = c & 31, ob = rr * 64 + cc * 2; return st * 1024 + (ob ^ (((ob >> 9) & 1) << 5)); }
__host__ __device__ __forceinline__ void stage_rc(int b, int& R, int& C) { const int st = b / 1024, sb = b % 1024, swz = sb ^ (((sb >> 9) & 1) << 5); R = (st >> 1) * 16 + swz / 64; C = (st & 1) * 32 + (swz % 64) / 2; }
__host__ __device__ __forceinline__ int perm32(int rho) { const int n = rho >> 4, i = rho & 15; return 8 * (i >> 2) + 4 * n + (i & 3); }

struct Unit { int pm, pn; };
struct Gemm { const bf16_t* A; const bf16_t* Bt; int lda, ldb, K; int gshift; unsigned goff; };

struct StaticOrder {
    int nM, nN, nwg, G, c, lim;
    __host__ __device__ void init(int M, int N, int G_, int c_) { nM = M / BM; nN = N / BM; nwg = nM * nN; G = G_; c = c_; lim = nwg; }
    __host__ __device__ bool next(int i, Unit& u) const {
        const long L = (long)i * G + c; if (L >= lim) return false;
        int wgid = (int)L; { const int q = nwg / NXCD, r = nwg % NXCD, xcd = wgid % NXCD, off = wgid / NXCD; wgid = (xcd < r ? xcd * (q + 1) : r * (q + 1) + (xcd - r) * q) + off; }
        const int nig = WGM * nN, gid = wgid / nig, fm = gid * WGM, gsz = (nM - fm) < WGM ? (nM - fm) : WGM;
        u.pm = fm + ((wgid % nig) % gsz); u.pn = (wgid % nig) / gsz; return true;
    }
    __device__ __forceinline__ void a_ready(const Unit&) const {}
    __device__ __forceinline__ void done(const Unit&) const {}
};


typedef float f32x2c __attribute__((ext_vector_type(2)));
typedef __bf16 bf16x2c __attribute__((ext_vector_type(2)));
__device__ __forceinline__ unsigned cvt_pk_bf16(float lo, float hi) { const f32x2c v = {lo, hi}; return __builtin_bit_cast(unsigned, __builtin_convertvector(v, bf16x2c)); }
__device__ __forceinline__ float bf_lo(unsigned w) { return __uint_as_float(w << 16); }
__device__ __forceinline__ float bf_hi(unsigned w) { return __uint_as_float(w & 0xffff0000u); }
__device__ __forceinline__ float sigmoidf_fast(float x) { return __builtin_amdgcn_rcpf(1.0f + __builtin_amdgcn_exp2f(-1.4426950408889634f * x)); }

struct EpiBf16 {
    static constexpr bool PERM = true, AFTER_DRAIN = false, USES_LDS = false;
    bf16_t* O; int ldc;
    __device__ __forceinline__ void operator()(const f32x4 (&acc)[2][2][4][2], const Unit& u, int wr, int wc, int fr, int fq) const {
        const int row0 = u.pm * BM + wr * 64 + fr, col0 = u.pn * BM + wc * 32 + 8 * fq;
#pragma unroll
        for (int ai = 0; ai < 2; ++ai)
#pragma unroll
            for (int m = 0; m < 4; ++m) { bf16_t* rowp = O + (size_t)(row0 + ai * HALF + m * 16) * ldc + col0;
#pragma unroll
                for (int bj = 0; bj < 2; ++bj) { const f32x4 v0 = acc[ai][bj][m][0], v1 = acc[ai][bj][m][1];
                    u32x4 w; w.x = cvt_pk_bf16(v0[0], v0[1]); w.y = cvt_pk_bf16(v0[2], v0[3]); w.z = cvt_pk_bf16(v1[0], v1[1]); w.w = cvt_pk_bf16(v1[2], v1[3]);
                    *(u32x4*)(rowp + bj * HALF) = w; } }
    }
};
struct EpiProj {
    static constexpr bool PERM = true, AFTER_DRAIN = false, USES_LDS = false;
    bf16_t *q, *k, *v, *u, *sa, *sp;
    __device__ __forceinline__ void operator()(const f32x4 (&acc)[2][2][4][2], const Unit& un, int wr, int wc, int fr, int fq) const {
        const int pn = un.pn; bf16_t* base; int ldc, ct; bool sg = false;
        if (pn < 8) { base = q; ldc = 2048; ct = pn; } else if (pn < 10) { base = k; ldc = 512; ct = pn - 8; } else if (pn < 12) { base = v; ldc = 512; ct = pn - 10; }
        else if (pn < 20) { base = u; ldc = 2048; ct = pn - 12; } else if (pn < 36) { base = sa; ldc = 4096; ct = pn - 20; sg = true; } else { base = sp; ldc = 4096; ct = pn - 36; sg = true; }
        const int row0 = un.pm * BM + wr * 64 + fr, col0 = ct * BM + wc * 32 + 8 * fq;
#pragma unroll
        for (int ai = 0; ai < 2; ++ai)
#pragma unroll
            for (int m = 0; m < 4; ++m) { bf16_t* rowp = base + (size_t)(row0 + ai * HALF + m * 16) * ldc + col0;
#pragma unroll
                for (int bj = 0; bj < 2; ++bj) { f32x4 v0 = acc[ai][bj][m][0], v1 = acc[ai][bj][m][1];
                    if (sg) {
#pragma unroll
                        for (int e = 0; e < 4; ++e) { v0[e] = sigmoidf_fast(v0[e]); v1[e] = sigmoidf_fast(v1[e]); } }
                    u32x4 w; w.x = cvt_pk_bf16(v0[0], v0[1]); w.y = cvt_pk_bf16(v0[2], v0[3]); w.z = cvt_pk_bf16(v1[0], v1[1]); w.w = cvt_pk_bf16(v1[2], v1[3]);
                    *(u32x4*)(rowp + bj * HALF) = w; } }
    }
};
struct EpiProj8 {
    static constexpr bool PERM = true, AFTER_DRAIN = false, USES_LDS = false;
    bf16_t *q, *k, *v, *sa, *sp; float scale;
    __device__ __forceinline__ void operator()(const f32x4 (&acc)[2][2][4][2], const Unit& un, int wr, int wc, int fr, int fq) const {
        const int pn = un.pn; bf16_t* base; int ldc, ct; bool sg = false;
        if (pn < 8) { base = q; ldc = 2048; ct = pn; } else if (pn < 10) { base = k; ldc = 512; ct = pn - 8; } else if (pn < 12) { base = v; ldc = 512; ct = pn - 10; }
        else if (pn < 28) { base = sa; ldc = 4096; ct = pn - 12; sg = true; } else { base = sp; ldc = 4096; ct = pn - 28; sg = true; }
        const int row0 = un.pm * BM + wr * 64 + fr, col0 = ct * BM + wc * 32 + 8 * fq;
#pragma unroll
        for (int ai = 0; ai < 2; ++ai)
#pragma unroll
            for (int m = 0; m < 4; ++m) { bf16_t* rowp = base + (size_t)(row0 + ai * HALF + m * 16) * ldc + col0;
#pragma unroll
                for (int bj = 0; bj < 2; ++bj) { f32x4 v0 = acc[ai][bj][m][0] * scale, v1 = acc[ai][bj][m][1] * scale;
                    if (sg) {
#pragma unroll
                        for (int e = 0; e < 4; ++e) { v0[e] = sigmoidf_fast(v0[e]); v1[e] = sigmoidf_fast(v1[e]); } }
                    u32x4 w; w.x = cvt_pk_bf16(v0[0], v0[1]); w.y = cvt_pk_bf16(v0[2], v0[3]); w.z = cvt_pk_bf16(v1[0], v1[1]); w.w = cvt_pk_bf16(v1[2], v1[3]);
                    *(PG8_GAS u32x4*)(rowp + bj * HALF) = w; } }
    }
};
struct EpiPool {
    static constexpr bool PERM = true, AFTER_DRAIN = false, USES_LDS = false;
    bf16_t* sp; const float* ps;
    __device__ __forceinline__ void operator()(const f32x4 (&acc)[2][2][4][2], const Unit& un, int wr, int wc, int fr, int fq) const {
        const int row0 = un.pm * BM + wr * 64 + fr, col0 = un.pn * BM + wc * 32 + 8 * fq;
        f32x4 sc[2][2];
#pragma unroll
        for (int bj = 0; bj < 2; ++bj)
#pragma unroll
            for (int n = 0; n < 2; ++n) sc[bj][n] = *(const PG8_GAS f32x4*)(ps + col0 + bj * HALF + 4 * n);
#pragma unroll
        for (int ai = 0; ai < 2; ++ai) {
            u32x4 gg[4][2];
#pragma unroll
            for (int m = 0; m < 4; ++m)
#pragma unroll
                for (int bj = 0; bj < 2; ++bj) gg[m][bj] = *(const PG8_GAS u32x4*)(sp + (size_t)(row0 + ai * HALF + m * 16) * 4096 + col0 + bj * HALF);
            asm volatile("" ::: "memory");
#pragma unroll
            for (int m = 0; m < 4; ++m)
#pragma unroll
                for (int bj = 0; bj < 2; ++bj) { const u32x4 g = gg[m][bj];
                    const f32x4 v0 = acc[ai][bj][m][0] * sc[bj][0], v1 = acc[ai][bj][m][1] * sc[bj][1];
                    u32x4 w; w.x = cvt_pk_bf16(v0[0] * bf_lo(g.x), v0[1] * bf_hi(g.x)); w.y = cvt_pk_bf16(v0[2] * bf_lo(g.y), v0[3] * bf_hi(g.y));
                    w.z = cvt_pk_bf16(v1[0] * bf_lo(g.z), v1[1] * bf_hi(g.z)); w.w = cvt_pk_bf16(v1[2] * bf_lo(g.w), v1[3] * bf_hi(g.w));
                    *(PG8_GAS u32x4*)(sp + (size_t)(row0 + ai * HALF + m * 16) * 4096 + col0 + bj * HALF) = w; }
        }
    }
};
struct EpiMerge {
    static constexpr bool PERM = true, AFTER_DRAIN = false, USES_LDS = false;
    bf16_t* sa; const bf16_t* P; float scale;
    __device__ __forceinline__ void operator()(const f32x4 (&acc)[2][2][4][2], const Unit& un, int wr, int wc, int fr, int fq) const {
        const int row0 = un.pm * BM + wr * 64 + fr, col0 = un.pn * BM + wc * 32 + 8 * fq;
#pragma unroll
        for (int ai = 0; ai < 2; ++ai) {
            u32x4 gg[4][2], pp[4][2];
#pragma unroll
            for (int m = 0; m < 4; ++m)
#pragma unroll
                for (int bj = 0; bj < 2; ++bj) { const size_t off = (size_t)(row0 + ai * HALF + m * 16) * 4096 + col0 + bj * HALF; gg[m][bj] = *(const PG8_GAS u32x4*)(sa + off); pp[m][bj] = *(const PG8_GAS u32x4*)(P + off); }
            asm volatile("" ::: "memory");
#pragma unroll
            for (int m = 0; m < 4; ++m)
#pragma unroll
                for (int bj = 0; bj < 2; ++bj) { const u32x4 g = gg[m][bj], p = pp[m][bj]; const f32x4 v0 = acc[ai][bj][m][0] * scale, v1 = acc[ai][bj][m][1] * scale;
                    u32x4 w; w.x = cvt_pk_bf16(v0[0] * bf_lo(g.x) + bf_lo(p.x), v0[1] * bf_hi(g.x) + bf_hi(p.x)); w.y = cvt_pk_bf16(v0[2] * bf_lo(g.y) + bf_lo(p.y), v0[3] * bf_hi(g.y) + bf_hi(p.y));
                    w.z = cvt_pk_bf16(v1[0] * bf_lo(g.z) + bf_lo(p.z), v1[1] * bf_hi(g.z) + bf_hi(p.z)); w.w = cvt_pk_bf16(v1[2] * bf_lo(g.w) + bf_lo(p.w), v1[3] * bf_hi(g.w) + bf_hi(p.w));
                    *(PG8_GAS u32x4*)(sa + (size_t)(row0 + ai * HALF + m * 16) * 4096 + col0 + bj * HALF) = w; }
        }
    }
};
struct EpiResF32 {
    static constexpr bool PERM = false, AFTER_DRAIN = false, USES_LDS = false;
    const float* base; const float* base2; int split_pm; float* out;
    __device__ __forceinline__ void operator()(const f32x4 (&acc)[2][2][4][2], const Unit& un, int wr, int wc, int fr, int fq) const {
        const int rloc = wr * 64 + fr, col0 = un.pn * BM + wc * 32 + 4 * fq;
        const float* bs = un.pm < split_pm ? base + (size_t)un.pm * BM * 4096 : base2 + (size_t)(un.pm - split_pm) * BM * 4096;
        float* os = out + (size_t)un.pm * BM * 4096;
#pragma unroll
        for (int ai = 0; ai < 2; ++ai)
#pragma unroll
            for (int m = 0; m < 4; ++m) { const size_t off = (size_t)(rloc + ai * HALF + m * 16) * 4096 + col0;
#pragma unroll
                for (int bj = 0; bj < 2; ++bj)
#pragma unroll
                    for (int n = 0; n < 2; ++n) { const f32x4 b = *(const f32x4*)(bs + off + bj * HALF + n * 16); *(f32x4*)(os + off + bj * HALF + n * 16) = b + acc[ai][bj][m][n]; } }
    }
};


struct EpiResNorm {
    static constexpr bool PERM = true, AFTER_DRAIN = false, USES_LDS = true, HALF_OK = true;
    const float* base; const float* base2; int split_pm; bf16_t* hb16; float* ssq;
    __device__ __forceinline__ void run(const f32x4 (&acc)[2][2][4][2], const Unit& un, int wr, int wc, int fr, int fq, PG8_LAS unsigned char* xl) const {
        asm volatile("" : "+v"(fr));
        const int rloc = wr * 64 + fr, col0 = un.pn * BM + wc * 32 + 8 * fq;
        const float* bs = un.pm < split_pm ? base + (size_t)un.pm * BM * 4096 : base2 + (size_t)(un.pm - split_pm) * BM * 4096;
        bf16_t* hs = hb16 + (size_t)un.pm * BM * 4096;
        PG8_LAS float* X = (PG8_LAS float*)xl;
#pragma unroll
        for (int ai = 0; ai < 2; ++ai) {
            f32x4 bb[4][2][2];
#pragma unroll
            for (int m = 0; m < 4; ++m)
#pragma unroll
                for (int bj = 0; bj < 2; ++bj)
#pragma unroll
                    for (int n = 0; n < 2; ++n) bb[m][bj][n] = *(const PG8_GAS f32x4*)(bs + (size_t)(rloc + ai * HALF + m * 16) * 4096 + col0 + bj * HALF + 4 * n);
            asm volatile("" ::: "memory");
#pragma unroll
            for (int m = 0; m < 4; ++m) { float s = 0.f;
#pragma unroll
                for (int bj = 0; bj < 2; ++bj) { const f32x4 h0 = bb[m][bj][0] + acc[ai][bj][m][0], h1 = bb[m][bj][1] + acc[ai][bj][m][1];
                    s += ((h0[0] * h0[0] + h0[1] * h0[1]) + (h0[2] * h0[2] + h0[3] * h0[3])) + ((h1[0] * h1[0] + h1[1] * h1[1]) + (h1[2] * h1[2] + h1[3] * h1[3]));
                    u32x4 w; w.x = cvt_pk_bf16(h0[0], h0[1]); w.y = cvt_pk_bf16(h0[2], h0[3]); w.z = cvt_pk_bf16(h1[0], h1[1]); w.w = cvt_pk_bf16(h1[2], h1[3]);
                    *(PG8_GAS u32x4*)(hs + (size_t)(rloc + ai * HALF + m * 16) * 4096 + col0 + bj * HALF) = w; }
                s += __shfl_xor(s, 16); s += __shfl_xor(s, 32);
                if (fq == 0) X[wc * 256 + rloc + ai * HALF + m * 16] = s; }
        }
        asm volatile("s_waitcnt lgkmcnt(0)" ::: "memory"); __builtin_amdgcn_s_barrier(); asm volatile("" ::: "memory");
        const int th = wc * 64 + fq * 16 + fr;
        if (th < 128) { const int t = wr * 64 + (th & 63) + (th >> 6) * 128; atomicAdd(ssq + (size_t)un.pm * BM + t, (X[t] + X[256 + t]) + (X[512 + t] + X[768 + t])); }
    }
};
struct EpiResBf16 {
    static constexpr bool PERM = true, AFTER_DRAIN = false, USES_LDS = false;
    bf16_t* h;
    __device__ __forceinline__ void operator()(const f32x4 (&acc)[2][2][4][2], const Unit& un, int wr, int wc, int fr, int fq) const {
        const int row0 = un.pm * BM + wr * 64 + fr, col0 = un.pn * BM + wc * 32 + 8 * fq;
        u32x4 rr[2][4][2];
#pragma unroll
        for (int ai = 0; ai < 2; ++ai)
#pragma unroll
            for (int m = 0; m < 4; ++m)
#pragma unroll
                for (int bj = 0; bj < 2; ++bj) rr[ai][m][bj] = *(const PG8_GAS u32x4*)((PG8_GAS bf16_t*)h + (size_t)(row0 + ai * HALF + m * 16) * 4096 + col0 + bj * HALF);
        asm volatile("" ::: "memory");
#pragma unroll
        for (int ai = 0; ai < 2; ++ai)
#pragma unroll
            for (int m = 0; m < 4; ++m)
#pragma unroll
                for (int bj = 0; bj < 2; ++bj) { const u32x4 r = rr[ai][m][bj]; const f32x4 v0 = acc[ai][bj][m][0], v1 = acc[ai][bj][m][1];
                    u32x4 w; w.x = cvt_pk_bf16(v0[0] + bf_lo(r.x), v0[1] + bf_hi(r.x)); w.y = cvt_pk_bf16(v0[2] + bf_lo(r.y), v0[3] + bf_hi(r.y));
                    w.z = cvt_pk_bf16(v1[0] + bf_lo(r.z), v1[1] + bf_hi(r.z)); w.w = cvt_pk_bf16(v1[2] + bf_lo(r.w), v1[3] + bf_hi(r.w));
                    *(PG8_GAS u32x4*)((PG8_GAS bf16_t*)h + (size_t)(row0 + ai * HALF + m * 16) * 4096 + col0 + bj * HALF) = w; }
    }
};
__device__ __forceinline__ float dpp_ror1(float x)  { return __int_as_float(__builtin_amdgcn_update_dpp(0, __float_as_int(x), 0x121, 0xf, 0xf, true)); }
__device__ __forceinline__ float dpp_ror15(float x) { return __int_as_float(__builtin_amdgcn_update_dpp(0, __float_as_int(x), 0x12f, 0xf, 0xf, true)); }
__device__ __forceinline__ float fma_s(float a, float b, float c) { float d; asm("v_fma_f32 %0, %1, %2, %3" : "=v"(d) : "v"(a), "v"(b), "v"(c)); return d; }
__device__ __forceinline__ float mul_s(float a, float b) { float d; asm("v_mul_f32 %0, %1, %2" : "=v"(d) : "v"(a), "v"(b)); return d; }
#define PG8_ROR1(x) dpp_ror1(x)
#define PG8_ROR15(x) dpp_ror15(x)
struct EpiConvGlu {
    static constexpr bool PERM = true, AFTER_DRAIN = false, USES_LDS = true, HALF_OK = false;
    bf16_t* act; float* hb; const float* cw; const float* cb; int dff, nup; const float* ssq; float inv_n, eps;
    __device__ __forceinline__ void run(f32x4 (&acc)[2][2][4][2], const Unit& un, int wr, int wc, int fr, int fq, PG8_LAS unsigned char* xl) const {
        asm volatile("" : "+v"(fr), "+v"(fq));
        const int cl = wc * 32 + 8 * fq;
#pragma unroll
        for (int ai = 0; ai < 2; ++ai)
#pragma unroll
            for (int m = 0; m < 4; ++m) { const float iv = __builtin_amdgcn_rsqf(ssq[(size_t)un.pm * BM + wr * 64 + fr + ai * HALF + m * 16] * inv_n + eps);
#pragma unroll
                for (int bj = 0; bj < 2; ++bj)
#pragma unroll
                    for (int n = 0; n < 2; ++n) acc[ai][bj][m][n] = acc[ai][bj][m][n] * iv; }
        PG8_LAS float* X = (PG8_LAS float*)xl;
#pragma unroll
        for (int ai = 0; ai < 2; ++ai) { const int blk = ai * 2 + wr;
            if (fr == 0) {
#pragma unroll
                for (int bj = 0; bj < 2; ++bj) { *(PG8_LAS f32x4*)(X + (blk * 2 + 0) * 256 + bj * 128 + cl) = acc[ai][bj][0][0]; *(PG8_LAS f32x4*)(X + (blk * 2 + 0) * 256 + bj * 128 + cl + 4) = acc[ai][bj][0][1]; } }
            if (fr == 15) {
#pragma unroll
                for (int bj = 0; bj < 2; ++bj) { *(PG8_LAS f32x4*)(X + (blk * 2 + 1) * 256 + bj * 128 + cl) = acc[ai][bj][3][0]; *(PG8_LAS f32x4*)(X + (blk * 2 + 1) * 256 + bj * 128 + cl + 4) = acc[ai][bj][3][1]; } } }
        asm volatile("s_waitcnt lgkmcnt(0)" ::: "memory"); __builtin_amdgcn_s_barrier(); asm volatile("" ::: "memory");
        { float* hrow = hb + ((size_t)un.pm * 4) * nup + (size_t)un.pn * 256 + cl;
          if (wr == 0 && fr < 2) {
#pragma unroll
              for (int bj = 0; bj < 2; ++bj) { *(f32x4*)(hrow + (size_t)fr * nup + bj * 128) = acc[0][bj][0][0]; *(f32x4*)(hrow + (size_t)fr * nup + bj * 128 + 4) = acc[0][bj][0][1]; } }
          if (wr == 1 && fr >= 14) {
#pragma unroll
              for (int bj = 0; bj < 2; ++bj) { *(f32x4*)(hrow + (size_t)(fr - 12) * nup + bj * 128) = acc[1][bj][3][0]; *(f32x4*)(hrow + (size_t)(fr - 12) * nup + bj * 128 + 4) = acc[1][bj][3][1]; } } }
        const bool e0 = fr == 0, e15 = fr == 15;
        const int row0 = un.pm * BM + wr * 64 + fr;
        typedef unsigned u32x2 __attribute__((ext_vector_type(2)));
#pragma unroll
        for (int ai = 0; ai < 2; ++ai) { const int blk = ai * 2 + wr;
            u32x2 keep[4];
#pragma unroll
            for (int n = 0; n < 2; ++n) {
                const int j = un.pn * 128 + cl + 4 * n;
                const f32x4 w0g = *(const PG8_GAS f32x4*)(cw + j), w1g = *(const PG8_GAS f32x4*)(cw + nup + j), w2g = *(const PG8_GAS f32x4*)(cw + 2 * (size_t)nup + j), bg = *(const PG8_GAS f32x4*)(cb + j);
                const f32x4 w0v = *(const PG8_GAS f32x4*)(cw + dff + j), w1v = *(const PG8_GAS f32x4*)(cw + nup + dff + j), w2v = *(const PG8_GAS f32x4*)(cw + 2 * (size_t)nup + dff + j), bv = *(const PG8_GAS f32x4*)(cb + dff + j);
                f32x4 hpg, hpv, hng, hnv;
                if (blk > 0) { hpg = *(const PG8_LAS f32x4*)(X + ((blk - 1) * 2 + 1) * 256 + cl + 4 * n); hpv = *(const PG8_LAS f32x4*)(X + ((blk - 1) * 2 + 1) * 256 + 128 + cl + 4 * n); } else { hpg = (f32x4){0.f, 0.f, 0.f, 0.f}; hpv = hpg; }
                if (blk < 3) { hng = *(const PG8_LAS f32x4*)(X + ((blk + 1) * 2 + 0) * 256 + cl + 4 * n); hnv = *(const PG8_LAS f32x4*)(X + ((blk + 1) * 2 + 0) * 256 + 128 + cl + 4 * n); } else { hng = (f32x4){0.f, 0.f, 0.f, 0.f}; hnv = hng; }
#pragma unroll
                for (int m = 0; m < 4; ++m) {
                    float o[4];
#pragma unroll
                    for (int e = 0; e < 4; ++e) {
                        const float g = acc[ai][0][m][n][e], v = acc[ai][1][m][n][e];
                        const float gpe = m > 0 ? PG8_ROR1(acc[ai][0][m - 1][n][e]) : hpg[e], vpe = m > 0 ? PG8_ROR1(acc[ai][1][m - 1][n][e]) : hpv[e];
                        const float gne = m < 3 ? PG8_ROR15(acc[ai][0][m + 1][n][e]) : hng[e], vne = m < 3 ? PG8_ROR15(acc[ai][1][m + 1][n][e]) : hnv[e];
                        const float gpi = PG8_ROR1(g), vpi = PG8_ROR1(v), gni = PG8_ROR15(g), vni = PG8_ROR15(v);
                        const float gp = e0 ? gpe : gpi, vp = e0 ? vpe : vpi, gn = e15 ? gne : gni, vn = e15 ? vne : vni;
                        const float cg = fma_s(w2g[e], gn, fma_s(w1g[e], g, fma_s(w0g[e], gp, bg[e]))), cv = fma_s(w2v[e], vn, fma_s(w1v[e], v, fma_s(w0v[e], vp, bv[e])));
                        o[e] = (cg * cv) * __builtin_amdgcn_rcpf(1.0f + __builtin_amdgcn_exp2f(cg * -1.4426950408889634f));
                    }
                    if (n == 0) { keep[m].x = cvt_pk_bf16(o[0], o[1]); keep[m].y = cvt_pk_bf16(o[2], o[3]); }
                    else { u32x4 w; w.x = keep[m].x; w.y = keep[m].y; w.z = cvt_pk_bf16(o[0], o[1]); w.w = cvt_pk_bf16(o[2], o[3]);
                        *(PG8_GAS u32x4*)(act + (size_t)(row0 + ai * HALF + m * 16) * dff + j - 4) = w; }
                }
                __builtin_amdgcn_sched_barrier(0);
            }
        }
    }
};

typedef int i32x4v __attribute__((ext_vector_type(4)));
typedef int i32x8v __attribute__((ext_vector_type(8)));
__device__ __forceinline__ i32x8v cat8(bf16x8 a, bf16x8 b) { return __builtin_shufflevector(__builtin_bit_cast(i32x4v, a), __builtin_bit_cast(i32x4v, b), 0, 1, 2, 3, 4, 5, 6, 7); }
template <class Epi, class Sched, bool ALIGN_EPI = false, bool SP2 = false, bool F8 = false>
__device__ __forceinline__ void gemm_phase(PG8_LAS unsigned char* lds, const Gemm g, const Sched& S, const Epi& E) {
    int tid_ = threadIdx.x; asm volatile("" : "+v"(tid_));
    const int tid = tid_, wid = __builtin_amdgcn_readfirstlane(tid >> 6), lane = tid & 63, wr = wid >> 2, wc = wid & 3, fr = lane & 15, fq = lane >> 4;
    const int K = g.K, nt = K / BK;
    unsigned voffA[2], voffB[2];
#pragma unroll
    for (int i = 0; i < 2; ++i) { int R, C; stage_rc(tid * 16 + i * 8192, R, C); const int Rb = Epi::PERM ? ((R & ~31) + perm32(R & 31)) : R;
        voffA[i] = (unsigned)(R * g.lda + C) * 2u; voffB[i] = (unsigned)(Rb * g.ldb + C) * 2u; }
    const size_t kstep = (size_t)(BK * 2);
    const size_t hA = (size_t)HALF * g.lda * 2, hB = (size_t)HALF * g.ldb * 2;
    const size_t tA = 2 * hA, tB = 2 * hB;
    const unsigned ldsw = (unsigned)wid * 1024u;
    const int aoff = lds_byte(wr * 64 + fr, fq * 8), boff = lds_byte(wc * 32 + fr, fq * 8);
#define PG8_SA(b, h) (((b) * 2 + (h)) * HTB)
#define PG8_SB(b, h) ((4 + (b) * 2 + (h)) * HTB)
#define PG8_STAGE(bufoff, gbase, voff) do { _Pragma("unroll") for (int _i = 0; _i < 2; ++_i) \
        __builtin_amdgcn_global_load_lds((const unsigned*)((const char*)(gbase) + (voff)[_i]), (PG8_LAS unsigned*)(lds + (bufoff) + ldsw + _i * 8192), 16, 0, 0); } while (0)
#define PG8_LDA(dst, b, h) do { _Pragma("unroll") for (int m = 0; m < 4; ++m) _Pragma("unroll") for (int k = 0; k < 2; ++k) dst[m][k] = *(const PG8_LAS bf16x8*)(lds + PG8_SA(b, h) + aoff + m * 2048 + k * 1024); } while (0)
#define PG8_LDB(dst, b, h) do { _Pragma("unroll") for (int n = 0; n < 2; ++n) _Pragma("unroll") for (int k = 0; k < 2; ++k) dst[n][k] = *(const PG8_LAS bf16x8*)(lds + PG8_SB(b, h) + boff + n * 2048 + k * 1024); } while (0)
#define PG8_MMA(ai, bj, At, Bt) do { __builtin_amdgcn_s_setprio(1); \
    if constexpr (F8) { _Pragma("unroll") for (int m = 0; m < 4; ++m) _Pragma("unroll") for (int n = 0; n < 2; ++n) { const i32x8v a8_ = cat8(At[m][0], At[m][1]), b8_ = cat8(Bt[n][0], Bt[n][1]); \
        asm volatile("v_mfma_scale_f32_16x16x128_f8f6f4 %0, %1, %2, %0, %3, %3 op_sel_hi:[0,0,0]" : "+v"(acc[ai][bj][m][n]) : "v"(b8_), "v"(a8_), "v"(one8)); } } \
    else { _Pragma("unroll") for (int m = 0; m < 4; ++m) _Pragma("unroll") for (int n = 0; n < 2; ++n) _Pragma("unroll") for (int k = 0; k < 2; ++k) \
        acc[ai][bj][m][n] = __builtin_amdgcn_mfma_f32_16x16x32_bf16(Bt[n][k], At[m][k], acc[ai][bj][m][n], 0, 0, 0); } \
    __builtin_amdgcn_s_setprio(0); } while (0)
#define PG8_WAIT_V(n) asm volatile("s_waitcnt vmcnt(" #n ")" ::: "memory")
#define PG8_WAIT_L(n) asm volatile("s_waitcnt lgkmcnt(" #n ")" ::: "memory")
#define PG8_BAR __builtin_amdgcn_s_barrier()
#define PG8_SCHED __builtin_amdgcn_sched_barrier(0)
    int one8 = 0x7f7f7f7f; asm volatile("" : "+v"(one8));
    Unit cur, nxt; int ui = 0;
    if (!S.next(0, cur)) return;
    f32x4 acc[2][2][4][2];
#pragma unroll
    for (int a = 0; a < 2; ++a)
#pragma unroll
        for (int b = 0; b < 2; ++b)
#pragma unroll
            for (int m = 0; m < 4; ++m)
#pragma unroll
                for (int n = 0; n < 2; ++n) acc[a][b][m][n] = (f32x4){0.f, 0.f, 0.f, 0.f};
    bf16x8 At[4][2], B0[2][2], B1[2][2];
    const char* cA = (const char*)g.A + (size_t)cur.pm * tA + (size_t)(cur.pn >> g.gshift) * g.goff; const char* cB = (const char*)g.Bt + (size_t)cur.pn * tB;
    S.a_ready(cur);
    if constexpr (SP2) {
        PG8_STAGE(PG8_SB(0, 0), cB, voffB); PG8_STAGE(PG8_SB(0, 1), cB + hB, voffB); PG8_STAGE(PG8_SA(0, 0), cA, voffA); PG8_STAGE(PG8_SA(0, 1), cA + hA, voffA);
        if (wr == 1) PG8_BAR;
        PG8_WAIT_V(2); PG8_BAR;
        PG8_STAGE(PG8_SB(1, 0), cB + kstep, voffB); PG8_STAGE(PG8_SA(1, 0), cA + kstep, voffA); PG8_STAGE(PG8_SB(1, 1), cB + hB + kstep, voffB);
        PG8_WAIT_V(6); PG8_BAR;
    } else {
        PG8_STAGE(PG8_SB(0, 0), cB, voffB); PG8_STAGE(PG8_SA(0, 0), cA, voffA); PG8_STAGE(PG8_SB(0, 1), cB + hB, voffB); PG8_STAGE(PG8_SA(0, 1), cA + hA, voffA);
        if (wr == 1) PG8_BAR;
        PG8_WAIT_V(4); PG8_BAR;
        PG8_STAGE(PG8_SB(1, 0), cB + kstep, voffB); PG8_STAGE(PG8_SA(1, 0), cA + kstep, voffA); PG8_STAGE(PG8_SB(1, 1), cB + hB + kstep, voffB);
        PG8_WAIT_V(6); PG8_BAR;
    }
    for (;;) {
        const bool has_next = S.next(ui + 1, nxt);
        const char* nA = has_next ? (const char*)g.A + (size_t)nxt.pm * tA + (size_t)(nxt.pn >> g.gshift) * g.goff : cA; const char* nB = has_next ? (const char*)g.Bt + (size_t)nxt.pn * tB : cB;
        for (int t = 0; t < nt; t += 2) {
            const bool last = (t == nt - 2);
            const char* a1 = cA + (size_t)(t + 1) * kstep;
            const char* a2 = last ? nA : cA + (size_t)(t + 2) * kstep; const char* b2 = last ? nB : cB + (size_t)(t + 2) * kstep;
            const char* a3 = a2 + kstep; const char* b3 = b2 + kstep;
            if (last && has_next) S.a_ready(nxt);
            if constexpr (SP2) {
            PG8_LDB(B0, 0, 0); PG8_LDB(B1, 0, 1); PG8_SCHED; PG8_LDA(At, 0, 0); PG8_STAGE(PG8_SA(1, 1), a1 + hA, voffA);
            PG8_WAIT_V(8); PG8_WAIT_L(0); PG8_BAR; PG8_MMA(0, 0, At, B0); PG8_MMA(0, 1, At, B1); PG8_BAR; PG8_SCHED;
            PG8_LDA(At, 0, 1); PG8_STAGE(PG8_SB(0, 0), b2, voffB); PG8_STAGE(PG8_SB(0, 1), b2 + hB, voffB); PG8_STAGE(PG8_SA(0, 0), a2, voffA);
            PG8_WAIT_V(8); PG8_WAIT_L(0); PG8_BAR; PG8_MMA(1, 0, At, B0); PG8_MMA(1, 1, At, B1); PG8_BAR; PG8_SCHED;
            PG8_LDB(B0, 1, 0); PG8_LDB(B1, 1, 1); PG8_SCHED; PG8_LDA(At, 1, 0); PG8_STAGE(PG8_SA(0, 1), a2 + hA, voffA);
            PG8_WAIT_V(8); PG8_WAIT_L(0); PG8_BAR; PG8_MMA(0, 0, At, B0); PG8_MMA(0, 1, At, B1); PG8_BAR; PG8_SCHED;
            PG8_LDA(At, 1, 1); PG8_STAGE(PG8_SB(1, 0), b3, voffB); PG8_STAGE(PG8_SB(1, 1), b3 + hB, voffB); PG8_STAGE(PG8_SA(1, 0), a3, voffA);
            PG8_WAIT_V(8); PG8_WAIT_L(0); PG8_BAR; PG8_MMA(1, 0, At, B0); PG8_MMA(1, 1, At, B1); PG8_BAR; PG8_SCHED;
            } else {
            PG8_LDB(B0, 0, 0); PG8_SCHED; PG8_LDA(At, 0, 0); PG8_STAGE(PG8_SA(1, 1), a1 + hA, voffA);
            PG8_WAIT_L(8); PG8_BAR; PG8_WAIT_L(0); PG8_MMA(0, 0, At, B0); PG8_BAR; PG8_SCHED;
            PG8_LDB(B1, 0, 1); PG8_STAGE(PG8_SB(0, 0), b2, voffB);
            PG8_BAR; PG8_WAIT_L(0); PG8_MMA(0, 1, At, B1); PG8_BAR;
            PG8_LDA(At, 0, 1); PG8_STAGE(PG8_SA(0, 0), a2, voffA);
            PG8_BAR; PG8_WAIT_L(0); PG8_MMA(1, 0, At, B0); PG8_BAR; PG8_SCHED;
            PG8_STAGE(PG8_SB(0, 1), b2 + hB, voffB);
            PG8_WAIT_V(6); PG8_BAR; PG8_MMA(1, 1, At, B1); PG8_BAR;
            PG8_LDB(B0, 1, 0); PG8_SCHED; PG8_LDA(At, 1, 0); PG8_STAGE(PG8_SA(0, 1), a2 + hA, voffA);
            PG8_WAIT_L(8); PG8_BAR; PG8_WAIT_L(0); PG8_MMA(0, 0, At, B0); PG8_BAR; PG8_SCHED;
            PG8_LDB(B1, 1, 1); PG8_STAGE(PG8_SB(1, 0), b3, voffB);
            PG8_BAR; PG8_WAIT_L(0); PG8_MMA(0, 1, At, B1); PG8_BAR;
            PG8_LDA(At, 1, 1); PG8_STAGE(PG8_SA(1, 0), a3, voffA);
            PG8_BAR; PG8_WAIT_L(0); PG8_MMA(1, 0, At, B0); PG8_BAR; PG8_SCHED;
            PG8_STAGE(PG8_SB(1, 1), b3 + hB, voffB);
            PG8_WAIT_V(6); PG8_BAR; PG8_MMA(1, 1, At, B1); PG8_BAR;
            }
        }
        if constexpr (ALIGN_EPI) { if (wr == 0) PG8_BAR; }
        if constexpr (F8) asm volatile("s_nop 15\n\ts_nop 15\n\ts_nop 7" ::: "memory");
        if constexpr (!Epi::AFTER_DRAIN) { if constexpr (Epi::USES_LDS) { static_assert(ALIGN_EPI || Epi::HALF_OK, "an epilogue whose exchange crosses the two halves needs them aligned"); E.run(acc, cur, wr, wc, fr, fq, lds + XL_OFF); } else E(acc, cur, wr, wc, fr, fq); S.done(cur); }
        if (!has_next) break;
#pragma unroll
        for (int a = 0; a < 2; ++a)
#pragma unroll
            for (int b = 0; b < 2; ++b)
#pragma unroll
                for (int m = 0; m < 4; ++m)
#pragma unroll
                    for (int n = 0; n < 2; ++n) acc[a][b][m][n] = (f32x4){0.f, 0.f, 0.f, 0.f};
        cur = nxt; cA = nA; cB = nB; ++ui;
        if constexpr (ALIGN_EPI) { if (wr == 1) PG8_BAR; }
    }
    PG8_WAIT_V(0);
    if constexpr (!ALIGN_EPI) { if (wr == 0) PG8_BAR; }
    PG8_BAR;
    if constexpr (Epi::AFTER_DRAIN) { E.fused(acc, cur, wr, wc, fr, fq, lds, wid, lane); S.done(cur); }
#undef PG8_SA
#undef PG8_SB
#undef PG8_STAGE
#undef PG8_LDA
#undef PG8_LDB
#undef PG8_MMA
#undef PG8_WAIT_V
#undef PG8_WAIT_L
#undef PG8_BAR
#undef PG8_SCHED
}
}

namespace att {
#define ATT_LAS __attribute__((address_space(3)))
typedef unsigned short bf16_t;
using bf16x8 = __attribute__((ext_vector_type(8))) short;
using s16x4  = __attribute__((ext_vector_type(4))) short;
using f32x16 = __attribute__((ext_vector_type(16))) float;
using u32x4  = __attribute__((ext_vector_type(4))) unsigned;
constexpr int   D = 128, NW = 8, QBLK = 32, KVBLK = 64;
constexpr float SCALE = 0.088388347648318440f;
constexpr float THR = 8.f;
#ifndef ATT_SDEPTH
#define ATT_SDEPTH 1
#endif
constexpr int SDEPTH = ATT_SDEPTH;
constexpr int LDQ = 2048, LDK = 512, LDO = 2048;
constexpr int SHM_V = KVBLK * D * 2, SHM_K = KVBLK * D * 2, SHM_ATTN = 2 * SHM_V + 2 * SHM_K + NW * 64 * 4;
#define KSWZ(row, colB) ((row) * 256 + ((colB) ^ (((row) & 7) << 4)))
#define SBAR() __builtin_amdgcn_sched_barrier(0)
__device__ __forceinline__ int crow(int r, int hi) { return (r & 3) + 8 * (r >> 2) + 4 * hi; }
__device__ __forceinline__ unsigned cvtpk(float lo, float hi) { return pg8::cvt_pk_bf16(lo, hi); }

__device__ __forceinline__ void partialSM(f32x16& p0, f32x16& p1, float& m_reg, float& mn, float& alpha) {
  constexpr float C = SCALE * 1.4426950408889634f;
  float pmax = p0[0];
#pragma unroll
  for (int r = 1; r < 16; ++r) pmax = fmaxf(pmax, p0[r]);
#pragma unroll
  for (int r = 0; r < 16; ++r) pmax = fmaxf(pmax, p1[r]);
  { auto rr = __builtin_amdgcn_permlane32_swap(__float_as_uint(pmax), __float_as_uint(pmax), false, false);
    pmax = fmaxf(__uint_as_float(rr[0]), __uint_as_float(rr[1])); }
  if (__builtin_expect(__all(pmax - m_reg <= THR / SCALE), 1)) { mn = m_reg; alpha = 1.f; }
  else { mn = fmaxf(m_reg, pmax); alpha = __builtin_amdgcn_exp2f((m_reg - mn) * C); m_reg = mn; }
  float mnC = -mn * C;
#pragma unroll
  for (int r = 0; r < 16; ++r) p0[r] = fmaf(p0[r], C, mnC);
#pragma unroll
  for (int r = 0; r < 16; ++r) p1[r] = fmaf(p1[r], C, mnC);
#pragma unroll
  for (int r = 0; r < 16; ++r) p0[r] = __builtin_amdgcn_exp2f(p0[r]);
}
__device__ __forceinline__ void finishSM(f32x16& p0, f32x16& p1, float alpha, float& l_reg, bf16x8& pa0, bf16x8& pa1, bf16x8& pa2, bf16x8& pa3) {
#pragma unroll
  for (int r = 0; r < 16; ++r) p1[r] = __builtin_amdgcn_exp2f(p1[r]);
  float ps = 0;
#pragma unroll
  for (int r = 0; r < 16; ++r) ps += p0[r];
#pragma unroll
  for (int r = 0; r < 16; ++r) ps += p1[r];
  { auto rr = __builtin_amdgcn_permlane32_swap(__float_as_uint(ps), __float_as_uint(ps), false, false);
    ps = __uint_as_float(rr[0]) + __uint_as_float(rr[1]); }
  l_reg = l_reg * alpha + ps;
#define PK4(P, BASE, OUT) do { unsigned a0 = cvtpk(P[BASE + 0], P[BASE + 1]), a1 = cvtpk(P[BASE + 2], P[BASE + 3]);   \
    unsigned b0 = cvtpk(P[BASE + 4], P[BASE + 5]), b1 = cvtpk(P[BASE + 6], P[BASE + 7]);                              \
    auto r0 = __builtin_amdgcn_permlane32_swap(a0, b0, false, false); auto r1 = __builtin_amdgcn_permlane32_swap(a1, b1, false, false); \
    u32x4 w = {r0[0], r1[0], r0[1], r1[1]}; OUT = *reinterpret_cast<bf16x8*>(&w); } while (0)
  PK4(p0, 0, pa0); PK4(p0, 8, pa1); PK4(p1, 0, pa2); PK4(p1, 8, pa3);
#undef PK4
}
__device__ __forceinline__ void qkt(f32x16& p0, f32x16& p1, const ATT_LAS char* Ks, const bf16x8* qr, int r32, int hi) {
  p0 = f32x16{}; p1 = f32x16{};
#pragma unroll
  for (int d0 = 0; d0 < 8; ++d0) { const int cb = (d0 * 16 + hi * 8) * 2;
    const bf16x8 b0 = *reinterpret_cast<const ATT_LAS bf16x8*>(Ks + KSWZ(r32, cb));
    const bf16x8 b1 = *reinterpret_cast<const ATT_LAS bf16x8*>(Ks + KSWZ(32 + r32, cb));
    p0 = __builtin_amdgcn_mfma_f32_32x32x16_bf16(b0, qr[d0], p0, 0, 0, 0);
    p1 = __builtin_amdgcn_mfma_f32_32x32x16_bf16(b1, qr[d0], p1, 0, 0, 0); }
}
__device__ __forceinline__ int v_st(int k, int c) { const int kk = (k & ~0xC) | ((k & 4) << 1) | ((k & 8) >> 1); return ((kk >> 3) * 4 + (c >> 5)) * 512 + ((kk & 7) * 32 + (c & 31)) * 2; }
__device__ __forceinline__ int v_rd_base(int lane) { return ((lane & 3) << 3) | (((lane >> 2) & 3) << 6) | (((lane >> 4) & 1) << 5) | (((lane >> 5) & 1) << 8); }
constexpr int v_rd_off(int d0, int ks, int half) { return d0 * 512 + ks * 4096 + half * 2048; }
template <int OFF> __device__ __forceinline__ s16x4 tr_read(int vb) {
  s16x4 r; asm volatile("ds_read_b64_tr_b16 %0, %1 offset:%2" : "=&v"(r) : "v"(vb), "i"(OFF) : "memory"); return r;
}
template <int D0> __device__ __forceinline__ void pv_one(f32x16& od, int vb, bf16x8 pa0, bf16x8 pa1, bf16x8 pa2, bf16x8 pa3) {
  const s16x4 l0 = tr_read<v_rd_off(D0, 0, 0)>(vb), h0 = tr_read<v_rd_off(D0, 0, 1)>(vb), l1 = tr_read<v_rd_off(D0, 1, 0)>(vb), h1 = tr_read<v_rd_off(D0, 1, 1)>(vb);
  const s16x4 l2 = tr_read<v_rd_off(D0, 2, 0)>(vb), h2 = tr_read<v_rd_off(D0, 2, 1)>(vb), l3 = tr_read<v_rd_off(D0, 3, 0)>(vb), h3 = tr_read<v_rd_off(D0, 3, 1)>(vb);
  asm volatile("s_waitcnt lgkmcnt(0)" ::: "memory"); SBAR();
#define PK(L, H) (bf16x8){L[0], L[1], L[2], L[3], H[0], H[1], H[2], H[3]}
  od = __builtin_amdgcn_mfma_f32_32x32x16_bf16(pa0, PK(l0, h0), od, 0, 0, 0);
  od = __builtin_amdgcn_mfma_f32_32x32x16_bf16(pa1, PK(l1, h1), od, 0, 0, 0);
  od = __builtin_amdgcn_mfma_f32_32x32x16_bf16(pa2, PK(l2, h2), od, 0, 0, 0);
  od = __builtin_amdgcn_mfma_f32_32x32x16_bf16(pa3, PK(l3, h3), od, 0, 0, 0);
#undef PK
}
__device__ __forceinline__ void pv_d0(f32x16* o, int vb, bf16x8 pa0, bf16x8 pa1, bf16x8 pa2, bf16x8 pa3) {
  pv_one<0>(o[0], vb, pa0, pa1, pa2, pa3); pv_one<1>(o[1], vb, pa0, pa1, pa2, pa3); pv_one<2>(o[2], vb, pa0, pa1, pa2, pa3); pv_one<3>(o[3], vb, pa0, pa1, pa2, pa3);
}
constexpr float O8SCALE = 16.0f;
__device__ __forceinline__ void attn_unit(const bf16_t* __restrict__ Qb, const bf16_t* __restrict__ Kh, const bf16_t* __restrict__ Vh, unsigned char* __restrict__ Ob, int seq, ATT_LAS char* lds,
                                          const float* __restrict__ qg, const float* __restrict__ tab, int tpos0) {
  int tid_ = threadIdx.x; asm volatile("" : "+v"(tid_));
  const int tid = tid_, wid = tid >> 6, lane = tid & 63, r32 = lane & 31, hi = lane >> 5;
  ATT_LAS char* V_lds = lds; ATT_LAS char* K_lds = lds + 2 * SHM_V;
  ATT_LAS float* ws = (ATT_LAS float*)(lds + 2 * SHM_V + 2 * SHM_K) + wid * 64; ATT_LAS float* li_l = ws; ATT_LAS float* al_l = ws + 32;
  float m_reg = -1e30f, l_reg = 0; f32x16 o[4] = {}; bf16x8 qr[8];
  const bf16_t* Qw = Qb + (long)(wid * QBLK + r32) * LDQ + hi * 8;
#pragma unroll
  for (int d0 = 0; d0 < 8; ++d0) qr[d0] = *reinterpret_cast<const bf16x8*>(Qw + d0 * 16);
  {
    typedef float f32x4a __attribute__((ext_vector_type(4)));
    float x[8][8]; float ss = 0.f;
#pragma unroll
    for (int d0 = 0; d0 < 8; ++d0)
#pragma unroll
      for (int e = 0; e < 8; ++e) { x[d0][e] = __uint_as_float((unsigned)(unsigned short)qr[d0][e] << 16); ss += x[d0][e] * x[d0][e]; }
    { auto rr = __builtin_amdgcn_permlane32_swap(__float_as_uint(ss), __float_as_uint(ss), false, false); ss = __uint_as_float(rr[0]) + __uint_as_float(rr[1]); }
    const float inv = 1.0f / sqrtf(ss * (1.0f / 128.0f) + 1e-6f);
#pragma unroll
    for (int d0 = 0; d0 < 8; ++d0) { const f32x4a g0 = *reinterpret_cast<const f32x4a*>(qg + d0 * 16 + hi * 8), g1 = *reinterpret_cast<const f32x4a*>(qg + d0 * 16 + hi * 8 + 4);
#pragma unroll
      for (int e = 0; e < 4; ++e) { x[d0][e] = x[d0][e] * inv * g0[e]; x[d0][4 + e] = x[d0][4 + e] * inv * g1[e]; } }
    const int tq = tpos0 + wid * QBLK + r32;
#pragma unroll
    for (int ax = 0; ax < 2; ++ax) { const int pos = ax == 0 ? (tq >> 6) : (tq & 63);
#pragma unroll
      for (int h = 0; h < 2; ++h) { const f32x4a* tp = reinterpret_cast<const f32x4a*>(tab + (size_t)(pos * 32 + h * 16 + hi * 8) * 2);
#pragma unroll
        for (int e2 = 0; e2 < 4; ++e2) { const f32x4a cs = tp[e2];
#pragma unroll
          for (int k = 0; k < 2; ++k) { const int e = 2 * e2 + k; const float c = cs[2 * k], s = cs[2 * k + 1]; const float u0 = x[ax * 4 + h][e], u1 = x[ax * 4 + 2 + h][e];
            x[ax * 4 + h][e] = u0 * c - u1 * s; x[ax * 4 + 2 + h][e] = u1 * c + u0 * s; } } } }
#pragma unroll
    for (int d0 = 0; d0 < 8; ++d0) { u32x4 w = {cvtpk(x[d0][0], x[d0][1]), cvtpk(x[d0][2], x[d0][3]), cvtpk(x[d0][4], x[d0][5]), cvtpk(x[d0][6], x[d0][7])}; qr[d0] = *reinterpret_cast<bf16x8*>(&w); }
  }
  const int sr = tid >> 4, sc = (tid & 15) * 8, vst0 = v_st(sr, sc), vst1 = v_st(32 + sr, sc);
  const int vb0 = (int)(uintptr_t)V_lds + v_rd_base(lane);
  bf16x8 sv0[SDEPTH], sv1[SDEPTH], sk0[SDEPTH], sk1[SDEPTH];
#define SLOAD(i, k0) do { sv0[i] = *reinterpret_cast<const bf16x8*>(&Vh[(long)((k0) + sr) * LDK + sc]); sv1[i] = *reinterpret_cast<const bf16x8*>(&Vh[(long)((k0) + 32 + sr) * LDK + sc]); \
    sk0[i] = *reinterpret_cast<const bf16x8*>(&Kh[(long)((k0) + sr) * LDK + sc]); sk1[i] = *reinterpret_cast<const bf16x8*>(&Kh[(long)((k0) + 32 + sr) * LDK + sc]); } while (0)
#define SWRITE(b, i) do { *(ATT_LAS bf16x8*)(V_lds + (b) * SHM_V + vst0) = sv0[i]; *(ATT_LAS bf16x8*)(V_lds + (b) * SHM_V + vst1) = sv1[i]; const int kc = sc * 2; \
    *(ATT_LAS bf16x8*)(K_lds + (b) * SHM_K + KSWZ(sr, kc)) = sk0[i]; *(ATT_LAS bf16x8*)(K_lds + (b) * SHM_K + KSWZ(32 + sr, kc)) = sk1[i]; } while (0)
#define SWAIT() do { if constexpr (SDEPTH == 2) asm volatile("s_waitcnt vmcnt(4)" ::: "memory"); else asm volatile("s_waitcnt vmcnt(0)" ::: "memory"); } while (0)
#define RESC(a) do { if (__any((a) < 1.f)) { if (hi == 0) al_l[r32] = (a); asm volatile("s_waitcnt lgkmcnt(0)" ::: "memory"); \
    _Pragma("unroll") for (int d = 0; d < 4; ++d) _Pragma("unroll") for (int r = 0; r < 16; ++r) o[d][r] *= al_l[crow(r, hi)]; } } while (0)
  f32x16 pA0, pA1, pB0, pB1; float mnA, mnB, alA, alB; bf16x8 pa0, pa1, pa2, pa3; const int NT = seq / KVBLK;
  constexpr int SE = 0, SO = SDEPTH - 1;
  SLOAD(SE, 0); asm volatile("s_waitcnt vmcnt(0)" ::: "memory"); SWRITE(0, SE); __syncthreads();
  qkt(pA0, pA1, K_lds, qr, r32, hi); partialSM(pA0, pA1, m_reg, mnA, alA);
  SLOAD(SO, KVBLK); if constexpr (SDEPTH == 2) { if (2 < NT) SLOAD(SE, 2 * KVBLK); }
  SWAIT(); SWRITE(1, SO); __syncthreads();
  for (int j = 1; j + 1 < NT; j += 2) {
    SBAR(); qkt(pB0, pB1, K_lds + SHM_K, qr, r32, hi);
    finishSM(pA0, pA1, alA, l_reg, pa0, pa1, pa2, pa3); SBAR();
    SLOAD(SO, (j + SDEPTH) * KVBLK); SBAR();
    pv_d0(o, vb0, pa0, pa1, pa2, pa3); partialSM(pB0, pB1, m_reg, mnB, alB);
    __syncthreads(); SWAIT(); SWRITE(0, SE);
    RESC(alB); __syncthreads();
    SBAR(); qkt(pA0, pA1, K_lds, qr, r32, hi);
    finishSM(pB0, pB1, alB, l_reg, pa0, pa1, pa2, pa3); SBAR();
    if (SDEPTH == 1 || j + 3 < NT) SLOAD(SE, (j + 1 + SDEPTH) * KVBLK); SBAR();
    pv_d0(o, vb0 + SHM_V, pa0, pa1, pa2, pa3); partialSM(pA0, pA1, m_reg, mnA, alA);
    __syncthreads(); SWAIT(); SWRITE(1, SO);
    RESC(alA); __syncthreads();
  }
  SBAR(); qkt(pB0, pB1, K_lds + SHM_K, qr, r32, hi);
  finishSM(pA0, pA1, alA, l_reg, pa0, pa1, pa2, pa3); SBAR();
  pv_d0(o, vb0, pa0, pa1, pa2, pa3); partialSM(pB0, pB1, m_reg, mnB, alB);
  __syncthreads(); RESC(alB);
  finishSM(pB0, pB1, alB, l_reg, pa0, pa1, pa2, pa3); SBAR();
  pv_d0(o, vb0 + SHM_V, pa0, pa1, pa2, pa3);
  if (hi == 0) li_l[r32] = l_reg; asm volatile("s_waitcnt lgkmcnt(0)" ::: "memory");
  float rli[16];
#pragma unroll
  for (int r = 0; r < 16; ++r) rli[r] = __builtin_amdgcn_rcpf(li_l[crow(r, hi)]);
  unsigned char* Ow = Ob + (long)(wid * QBLK) * LDO;
#pragma unroll
  for (int r = 0; r < 16; ++r) { const int orow = crow(r, hi);
#pragma unroll
    for (int d0 = 0; d0 < 4; ++d0) { const float x = o[d0][r] * rli[r] * O8SCALE; Ow[(long)orow * LDO + d0 * 32 + r32] = (unsigned char)(__builtin_amdgcn_cvt_pk_fp8_f32(x, x, 0, false) & 0xff); } }
  __syncthreads();
#undef SLOAD
#undef SWRITE
#undef SWAIT
#undef RESC
}
constexpr float THR8 = 5.f;
constexpr int VT_STRIDE = 4 * 8192;
typedef int i32x8a __attribute__((ext_vector_type(8)));
typedef int i32x4a __attribute__((ext_vector_type(4)));
__device__ __forceinline__ unsigned pk4f8(float a, float b, float c, float d) { unsigned w = 0u; w = __builtin_amdgcn_cvt_pk_fp8_f32(a, b, w, false); w = __builtin_amdgcn_cvt_pk_fp8_f32(c, d, w, true); return w; }
__device__ __forceinline__ i32x8a ld32(const ATT_LAS char* p0, const ATT_LAS char* p1) { const i32x4a a = *reinterpret_cast<const ATT_LAS i32x4a*>(p0), b = *reinterpret_cast<const ATT_LAS i32x4a*>(p1); return __builtin_shufflevector(a, b, 0, 1, 2, 3, 4, 5, 6, 7); }
#define MFMA8(acc, a8, b8, one) asm volatile("v_mfma_scale_f32_32x32x64_f8f6f4 %0, %1, %2, %0, %3, %3 op_sel_hi:[0,0,0]" : "+v"(acc) : "v"(a8), "v"(b8), "v"(one))
__device__ __forceinline__ void partialSM8(f32x16& p0, f32x16& p1, float& m_reg, float& mn, float& alpha) {
  constexpr float C = SCALE * 1.4426950408889634f;
  float pmax = p0[0];
#pragma unroll
  for (int r = 1; r < 16; ++r) pmax = fmaxf(pmax, p0[r]);
#pragma unroll
  for (int r = 0; r < 16; ++r) pmax = fmaxf(pmax, p1[r]);
  { auto rr = __builtin_amdgcn_permlane32_swap(__float_as_uint(pmax), __float_as_uint(pmax), false, false);
    pmax = fmaxf(__uint_as_float(rr[0]), __uint_as_float(rr[1])); }
  if (__builtin_expect(__all(pmax - m_reg <= THR8 / SCALE), 1)) { mn = m_reg; alpha = 1.f; }
  else { mn = fmaxf(m_reg, pmax); alpha = __builtin_amdgcn_exp2f((m_reg - mn) * C); m_reg = mn; }
  float mnC = -mn * C;
#pragma unroll
  for (int r = 0; r < 16; ++r) p0[r] = fmaf(p0[r], C, mnC);
#pragma unroll
  for (int r = 0; r < 16; ++r) p1[r] = fmaf(p1[r], C, mnC);
#pragma unroll
  for (int r = 0; r < 16; ++r) p0[r] = __builtin_amdgcn_exp2f(p0[r]);
}
__device__ __forceinline__ void finishSM8(f32x16& p0, f32x16& p1, float alpha, float& l_reg, i32x8a& pa) {
#pragma unroll
  for (int r = 0; r < 16; ++r) p1[r] = __builtin_amdgcn_exp2f(p1[r]);
  float ps = 0;
#pragma unroll
  for (int r = 0; r < 16; ++r) ps += p0[r];
#pragma unroll
  for (int r = 0; r < 16; ++r) ps += p1[r];
  { auto rr = __builtin_amdgcn_permlane32_swap(__float_as_uint(ps), __float_as_uint(ps), false, false);
    ps = __uint_as_float(rr[0]) + __uint_as_float(rr[1]); }
  l_reg = l_reg * alpha + ps;
  pa = (i32x8a){(int)pk4f8(p0[0], p0[1], p0[2], p0[3]), (int)pk4f8(p0[4], p0[5], p0[6], p0[7]), (int)pk4f8(p0[8], p0[9], p0[10], p0[11]), (int)pk4f8(p0[12], p0[13], p0[14], p0[15]),
                (int)pk4f8(p1[0], p1[1], p1[2], p1[3]), (int)pk4f8(p1[4], p1[5], p1[6], p1[7]), (int)pk4f8(p1[8], p1[9], p1[10], p1[11]), (int)pk4f8(p1[12], p1[13], p1[14], p1[15])};
}
__device__ __forceinline__ int k8_off(int key, int c) { return key * 128 + ((c ^ ((key >> 1) & 7)) << 4); }
__device__ __forceinline__ int v8_off(int n, int c) { return n * 64 + ((c ^ ((n >> 2) & 3)) << 4); }
template <bool WAITSTATES>
__device__ __forceinline__ void qkt8(f32x16& p0, f32x16& p1, const ATT_LAS char* Ks, const i32x8a (&q8)[2], int r32, int hi, int one) {
  p0 = f32x16{}; p1 = f32x16{};
  const i32x8a k00 = ld32(Ks + k8_off(r32, 2 * hi), Ks + k8_off(r32, 2 * hi + 1)), k10 = ld32(Ks + k8_off(32 + r32, 2 * hi), Ks + k8_off(32 + r32, 2 * hi + 1));
  const i32x8a k01 = ld32(Ks + k8_off(r32, 4 + 2 * hi), Ks + k8_off(r32, 5 + 2 * hi)), k11 = ld32(Ks + k8_off(32 + r32, 4 + 2 * hi), Ks + k8_off(32 + r32, 5 + 2 * hi));
  asm volatile("s_nop 1" ::: "memory");
  __builtin_amdgcn_s_setprio(1); MFMA8(p0, k00, q8[0], one); MFMA8(p1, k10, q8[0], one); MFMA8(p0, k01, q8[1], one); MFMA8(p1, k11, q8[1], one); __builtin_amdgcn_s_setprio(0);
  if (WAITSTATES) asm volatile("s_nop 15\n\ts_nop 7" ::: "memory");
}
template <bool WAITSTATES>
__device__ __forceinline__ void pv8(f32x16* o, const ATT_LAS char* Vs, const i32x8a& pa, int r32, int hi, int one) {
  const i32x8a v0 = ld32(Vs + v8_off(r32, 2 * hi), Vs + v8_off(r32, 2 * hi + 1)), v1 = ld32(Vs + v8_off(32 + r32, 2 * hi), Vs + v8_off(32 + r32, 2 * hi + 1));
  const i32x8a v2 = ld32(Vs + v8_off(64 + r32, 2 * hi), Vs + v8_off(64 + r32, 2 * hi + 1)), v3 = ld32(Vs + v8_off(96 + r32, 2 * hi), Vs + v8_off(96 + r32, 2 * hi + 1));
  __builtin_amdgcn_s_setprio(1); MFMA8(o[0], pa, v0, one); MFMA8(o[1], pa, v1, one); MFMA8(o[2], pa, v2, one); MFMA8(o[3], pa, v3, one); __builtin_amdgcn_s_setprio(0);
  if (WAITSTATES) asm volatile("s_nop 15\n\ts_nop 7" ::: "memory");
}
__device__ __forceinline__ void attn_unit8(const bf16_t* __restrict__ Qb, const unsigned char* __restrict__ K8h, const unsigned char* __restrict__ VT8h, unsigned char* __restrict__ Ob, int seq, ATT_LAS char* lds,
                                           const float* __restrict__ qg, const float* __restrict__ tab, int tpos0) {
  int tid_ = threadIdx.x; asm volatile("" : "+v"(tid_));
  const int tid = tid_, wid = tid >> 6, lane = tid & 63, r32 = lane & 31, hi = lane >> 5;
  int one = 0x7f7f7f7f; asm volatile("" : "+v"(one));
  ATT_LAS char* V_lds = lds; ATT_LAS char* K_lds = lds + 3 * 8192;
  ATT_LAS float* ws = (ATT_LAS float*)(lds + 6 * 8192) + wid * 64; ATT_LAS float* li_l = ws; ATT_LAS float* al_l = ws + 32;
  float m_reg = -1e30f, l_reg = 0; f32x16 o[4] = {}; i32x8a q8[2];
  const int krow = tid >> 3, kch = tid & 7, kst = k8_off(krow, kch), vst = v8_off(tid >> 2, tid & 3);
  const unsigned char* kg = K8h + (long)krow * 512 + kch * 16; const unsigned char* vg = VT8h + tid * 16;
  i32x4a sk[2], sv[2];
#define SLOAD8(i, t) do { sk[i] = *reinterpret_cast<const i32x4a*>(kg + (long)(t) * (64 * 512)); sv[i] = *reinterpret_cast<const i32x4a*>(vg + (long)(t) * VT_STRIDE); } while (0)
#define SWRITE8(b, i) do { *reinterpret_cast<ATT_LAS i32x4a*>(K_lds + (b) * 8192 + kst) = sk[i]; *reinterpret_cast<ATT_LAS i32x4a*>(V_lds + (b) * 8192 + vst) = sv[i]; } while (0)
#define SWAIT8() asm volatile("s_waitcnt vmcnt(2)" ::: "memory")
#define SWRITE8R(boff, i) do { *reinterpret_cast<ATT_LAS i32x4a*>(K_lds + (boff) + kst) = sk[i]; *reinterpret_cast<ATT_LAS i32x4a*>(V_lds + (boff) + vst) = sv[i]; } while (0)
#define RESC8(a) do { if (__any((a) < 1.f)) { if (hi == 0) al_l[r32] = (a); asm volatile("s_waitcnt lgkmcnt(0)" ::: "memory"); \
    _Pragma("unroll") for (int d = 0; d < 4; ++d) _Pragma("unroll") for (int r = 0; r < 16; ++r) o[d][r] *= al_l[crow(r, hi)]; } } while (0)
  const int NT = seq / KVBLK;
  SLOAD8(0, 0);
  {
    typedef float f32x4a __attribute__((ext_vector_type(4)));
    const bf16_t* Qw = Qb + (long)(wid * QBLK + r32) * LDQ + hi * 8;
    bf16x8 qr[8];
#pragma unroll
    for (int d0 = 0; d0 < 8; ++d0) qr[d0] = *reinterpret_cast<const bf16x8*>(Qw + d0 * 16);
    float x[8][8]; float ss = 0.f;
#pragma unroll
    for (int d0 = 0; d0 < 8; ++d0)
#pragma unroll
      for (int e = 0; e < 8; ++e) { x[d0][e] = __uint_as_float((unsigned)(unsigned short)qr[d0][e] << 16); ss += x[d0][e] * x[d0][e]; }
    { auto rr = __builtin_amdgcn_permlane32_swap(__float_as_uint(ss), __float_as_uint(ss), false, false); ss = __uint_as_float(rr[0]) + __uint_as_float(rr[1]); }
    const float inv = 1.0f / sqrtf(ss * (1.0f / 128.0f) + 1e-6f);
#pragma unroll
    for (int d0 = 0; d0 < 8; ++d0) { const f32x4a g0 = *reinterpret_cast<const f32x4a*>(qg + d0 * 16 + hi * 8), g1 = *reinterpret_cast<const f32x4a*>(qg + d0 * 16 + hi * 8 + 4);
#pragma unroll
      for (int e = 0; e < 4; ++e) { x[d0][e] = x[d0][e] * inv * g0[e]; x[d0][4 + e] = x[d0][4 + e] * inv * g1[e]; } }
    const int tq = tpos0 + wid * QBLK + r32;
#pragma unroll
    for (int ax = 0; ax < 2; ++ax) { const int pos = ax == 0 ? (tq >> 6) : (tq & 63);
#pragma unroll
      for (int h = 0; h < 2; ++h) { const f32x4a* tp = reinterpret_cast<const f32x4a*>(tab + (size_t)(pos * 32 + h * 16 + hi * 8) * 2);
#pragma unroll
        for (int e2 = 0; e2 < 4; ++e2) { const f32x4a cs = tp[e2];
#pragma unroll
          for (int k = 0; k < 2; ++k) { const int e = 2 * e2 + k; const float c = cs[2 * k], s = cs[2 * k + 1]; const float u0 = x[ax * 4 + h][e], u1 = x[ax * 4 + 2 + h][e];
            x[ax * 4 + h][e] = u0 * c - u1 * s; x[ax * 4 + 2 + h][e] = u1 * c + u0 * s; } } } }
#pragma unroll
    for (int s = 0; s < 2; ++s)
      q8[s] = (i32x8a){(int)pk4f8(x[4 * s][0], x[4 * s][1], x[4 * s][2], x[4 * s][3]), (int)pk4f8(x[4 * s][4], x[4 * s][5], x[4 * s][6], x[4 * s][7]),
                       (int)pk4f8(x[4 * s + 1][0], x[4 * s + 1][1], x[4 * s + 1][2], x[4 * s + 1][3]), (int)pk4f8(x[4 * s + 1][4], x[4 * s + 1][5], x[4 * s + 1][6], x[4 * s + 1][7]),
                       (int)pk4f8(x[4 * s + 2][0], x[4 * s + 2][1], x[4 * s + 2][2], x[4 * s + 2][3]), (int)pk4f8(x[4 * s + 2][4], x[4 * s + 2][5], x[4 * s + 2][6], x[4 * s + 2][7]),
                       (int)pk4f8(x[4 * s + 3][0], x[4 * s + 3][1], x[4 * s + 3][2], x[4 * s + 3][3]), (int)pk4f8(x[4 * s + 3][4], x[4 * s + 3][5], x[4 * s + 3][6], x[4 * s + 3][7])};
  }
  f32x16 pA0, pA1, pB0, pB1; float mnA, mnB, alA, alB; i32x8a pa;
  asm volatile("s_waitcnt vmcnt(0)" ::: "memory"); SWRITE8(0, 0); __syncthreads();
  qkt8<true>(pA0, pA1, K_lds, q8, r32, hi, one); partialSM8(pA0, pA1, m_reg, mnA, alA);
  SLOAD8(1, 1); if (2 < NT) SLOAD8(0, 2);
  SWAIT8(); SWRITE8(1, 1); __syncthreads();
  int bK = 8192, bV = 0, bW = 2 * 8192;
  for (int j = 1; j + 1 < NT; j += 2) {
    SBAR(); qkt8<false>(pB0, pB1, K_lds + bK, q8, r32, hi, one);
    finishSM8(pA0, pA1, alA, l_reg, pa); SBAR();
    SLOAD8(1, j + 2); SBAR();
    pv8<false>(o, V_lds + bV, pa, r32, hi, one); partialSM8(pB0, pB1, m_reg, mnB, alB);
    SWAIT8(); SWRITE8R(bW, 0);
    RESC8(alB); __syncthreads();
    { const int t = bV; bV = bK; bK = bW; bW = t; }
    SBAR(); qkt8<false>(pA0, pA1, K_lds + bK, q8, r32, hi, one);
    finishSM8(pB0, pB1, alB, l_reg, pa); SBAR();
    if (j + 3 < NT) SLOAD8(0, j + 3); SBAR();
    pv8<false>(o, V_lds + bV, pa, r32, hi, one); partialSM8(pA0, pA1, m_reg, mnA, alA);
    SWAIT8(); SWRITE8R(bW, 1);
    RESC8(alA); __syncthreads();
    { const int t = bV; bV = bK; bK = bW; bW = t; }
  }
  SBAR(); qkt8<false>(pB0, pB1, K_lds + bK, q8, r32, hi, one);
  finishSM8(pA0, pA1, alA, l_reg, pa); SBAR();
  pv8<false>(o, V_lds + bV, pa, r32, hi, one); partialSM8(pB0, pB1, m_reg, mnB, alB);
  RESC8(alB);
  finishSM8(pB0, pB1, alB, l_reg, pa); SBAR();
  pv8<true>(o, V_lds + bK, pa, r32, hi, one);
  if (hi == 0) li_l[r32] = l_reg; asm volatile("s_waitcnt lgkmcnt(0)" ::: "memory");
  float rli[16];
#pragma unroll
  for (int r = 0; r < 16; ++r) rli[r] = __builtin_amdgcn_rcpf(li_l[crow(r, hi)]);
  unsigned char* Ow = Ob + (long)(wid * QBLK) * LDO;
  ATT_LAS unsigned char* ot = (ATT_LAS unsigned char*)lds + 65536 + wid * (32 * 144);
#pragma unroll
  for (int r = 0; r < 16; ++r) { const int orow = crow(r, hi);
#pragma unroll
    for (int d0 = 0; d0 < 4; ++d0) { const float xo = o[d0][r] * rli[r] * O8SCALE; ot[orow * 144 + d0 * 32 + r32] = (unsigned char)(__builtin_amdgcn_cvt_pk_fp8_f32(xo, xo, 0, false) & 0xff); } }
  asm volatile("s_waitcnt lgkmcnt(0)" ::: "memory");
#pragma unroll
  for (int k = 0; k < 4; ++k) { const int p = lane + 64 * k, row = p >> 3, c = p & 7;
    const i32x4a v = *reinterpret_cast<const ATT_LAS i32x4a*>(ot + row * 144 + c * 16);
    *reinterpret_cast<i32x4a*>(Ow + (long)row * LDO + c * 16) = v; }
  __syncthreads();
#undef SLOAD8
#undef SWRITE8
#undef SWAIT8
#undef RESC8
}
}

constexpr int NWAVES = 8;
constexpr int DM = 4096, T_P = 16384, T_ALL = 24576, SEQ_P = 2048, SEQ_S = 4096;
constexpr int NQ = 2048, NKV = 512, NU = 2048, INW = 13312, DFF = 11008, NUP = 22016;
constexpr float EPS = 1e-6f;
constexpr size_t MiB = 1u << 20;
constexpr size_t WS_CTL = 0, CTL_ZERO_BYTES = 1 * MiB;
constexpr size_t WS_ROPE = 1 * MiB;
constexpr size_t WS_WIN = 2 * MiB;
constexpr size_t WS_WDOWN = WS_WIN;
constexpr size_t WS_WATT = 106 * MiB;
constexpr size_t WS_WPOOL = 122 * MiB;
constexpr size_t WS_WOUT = 126 * MiB;
constexpr size_t WS_WUP = 158 * MiB;
constexpr size_t WS_R1 = 330 * MiB;
constexpr size_t WS_D = WS_R1, WS_O = WS_R1 + 96 * MiB;
constexpr size_t WS_Q = 522 * MiB, WS_K = 618 * MiB, WS_V = 642 * MiB, WS_U = 666 * MiB, WS_SA = 762 * MiB, WS_SP = 954 * MiB;
constexpr size_t WS_ACT = 522 * MiB;
constexpr size_t WS_HB = 1038 * MiB;
constexpr size_t WS_END = 1146 * MiB;
static_assert(WS_WIN + (size_t)INW * DM * 2 == WS_WATT && WS_WUP + (size_t)NUP * DM * 2 == WS_R1 && WS_R1 + (size_t)T_ALL * DM * 2 == WS_Q, "ws map");
static_assert(WS_SP + (size_t)T_ALL * DM * 2 == WS_END && WS_ACT + (size_t)T_ALL * DFF * 2 == WS_HB && WS_HB + (size_t)96 * 4 * NUP * 4 <= WS_END, "ws map 2");
static_assert(WS_WDOWN + (size_t)DM * DFF * 2 <= WS_WATT, "ws map 3");
constexpr size_t WS_WIN8 = WS_WIN + 16 * MiB;
constexpr size_t N8_OFF = (size_t)DM * DFF * 2;
constexpr int I_DOWN_TAIL = 10240;
constexpr size_t WS_K8 = WS_O + 48 * MiB;
constexpr size_t WS_VT8 = WS_O + 60 * MiB;
constexpr int CW_BAR = 4096;
constexpr size_t CTL_TAILF = 262144;
constexpr size_t CTL_SSQ1 = 65536;
constexpr int RING_OFF = 0, RING_BYTES = 131072;
constexpr int LDSCTL_OFF = RING_BYTES, MISC_OFF = LDSCTL_OFF + 320;
constexpr int LDS_BYTES = 147456;

#define GAS __attribute__((address_space(1)))
#define LAS __attribute__((address_space(3)))
typedef unsigned short bf16;
typedef unsigned v4u __attribute__((ext_vector_type(4)));
typedef unsigned v2u __attribute__((ext_vector_type(2)));
typedef float f32x4 __attribute__((ext_vector_type(4)));
typedef float f32x2 __attribute__((ext_vector_type(2)));
typedef GAS unsigned gu32;
#define RLX_AGENT __ATOMIC_RELAXED, __HIP_MEMORY_SCOPE_AGENT
#define LDS_WAIT() asm volatile("s_waitcnt lgkmcnt(0)" ::: "memory")
#define VM_WAIT() asm volatile("s_waitcnt vmcnt(0)" ::: "memory")
__device__ __forceinline__ unsigned pk2(float lo, float hi) { return pg8::cvt_pk_bf16(lo, hi); }
__device__ __forceinline__ float bflo(unsigned w) { return __uint_as_float(w << 16); }
__device__ __forceinline__ float bfhi(unsigned w) { return __uint_as_float(w & 0xffff0000u); }

#define XB_TMO      128
#define XB_XCNT(j)  (256  + 64 * (j))
#define XB_XSUB(j)  (1280 + 64 * (j))
#define XB_XGEN(j)  (2304 + 64 * (j))
#define XB_TOP      3328
#define XB_TOPGEN   3392
#define XCD_BAR_WORDS 3456
#define XB_SPIN_CAP (1u << 18)
__device__ __forceinline__ unsigned xb_ld(unsigned* p)              { return __hip_atomic_load(p, __ATOMIC_RELAXED, __HIP_MEMORY_SCOPE_AGENT); }
__device__ __forceinline__ unsigned xb_add(unsigned* p, unsigned v) { return __hip_atomic_fetch_add(p, v, __ATOMIC_RELAXED, __HIP_MEMORY_SCOPE_AGENT); }
__device__ __forceinline__ unsigned xb_xcc_id() { return (unsigned)__builtin_amdgcn_s_getreg((3 << 11) | 20) & 0xFu; }
#define XB_SPIN(cond, bar) do { unsigned _sp = 0; while (cond) { __builtin_amdgcn_s_sleep(1); \
    if ((++_sp & 255u) == 0u) { if (xb_ld(&(bar)[XB_TMO])) break; if (_sp > XB_SPIN_CAP) { atomicAdd(&(bar)[XB_TMO], 1u); break; } } } } while (0)

namespace pg8 {
struct EpiConvGluTail {
    static constexpr bool PERM = true, AFTER_DRAIN = false, USES_LDS = true, HALF_OK = false;
    EpiConvGlu inner; float* part; unsigned* flag; unsigned* bar; int kpart, slot;
    __device__ __forceinline__ void run(f32x4 (&acc)[2][2][4][2], const Unit& un, int wr, int wc, int fr, int fq, PG8_LAS unsigned char* xl) const {
        int t = wr * 256 + wc * 64 + fq * 16 + fr; asm volatile("" : "+v"(t));
        if (kpart != 0) {
            PG8_GAS f32x4* dst = (PG8_GAS f32x4*)(part + ((size_t)(slot * 3 + kpart - 1) << 16)) + t;
#pragma unroll
            for (int ai = 0; ai < 2; ++ai)
#pragma unroll
                for (int bj = 0; bj < 2; ++bj)
#pragma unroll
                    for (int m = 0; m < 4; ++m)
#pragma unroll
                        for (int n = 0; n < 2; ++n) dst[(((ai * 2 + bj) * 4 + m) * 2 + n) * 512] = acc[ai][bj][m][n];
            asm volatile("s_waitcnt vmcnt(0)" ::: "memory"); __builtin_amdgcn_s_barrier();
            if (t == 0) { __builtin_amdgcn_fence(__ATOMIC_RELEASE, "agent"); asm volatile("s_waitcnt vmcnt(0)" ::: "memory"); (void)xb_add(flag + slot * 16, 1u); }
        } else {
            if (t == 0) { XB_SPIN(xb_ld(flag + slot * 16) < 3u, bar); __builtin_amdgcn_fence(__ATOMIC_ACQUIRE, "agent"); }
            asm volatile("s_waitcnt vmcnt(0)" ::: "memory"); __builtin_amdgcn_s_barrier(); asm volatile("" ::: "memory");
#pragma unroll
            for (int p = 0; p < 3; ++p) {
                const PG8_GAS f32x4* src = (const PG8_GAS f32x4*)(part + ((size_t)(slot * 3 + p) << 16)) + t;
#pragma unroll
                for (int ai = 0; ai < 2; ++ai)
#pragma unroll
                    for (int bj = 0; bj < 2; ++bj) {
                        f32x4 v[4][2];
#pragma unroll
                        for (int m = 0; m < 4; ++m)
#pragma unroll
                            for (int n = 0; n < 2; ++n) v[m][n] = src[(((ai * 2 + bj) * 4 + m) * 2 + n) * 512];
                        __builtin_amdgcn_sched_barrier(0);
#pragma unroll
                        for (int m = 0; m < 4; ++m)
#pragma unroll
                            for (int n = 0; n < 2; ++n) { acc[ai][bj][m][n] += v[m][n]; asm volatile("" : "+v"(acc[ai][bj][m][n])); }
                        __builtin_amdgcn_sched_barrier(0);
                    }
            }
            inner.run(acc, un, wr, wc, fr, fq, xl);
        }
    }
};
}

struct XcdBarrier {
    unsigned* bar; unsigned x;
    volatile LAS unsigned* st;
};

__device__ __forceinline__ XcdBarrier xcd_barrier_post(unsigned* bar, volatile LAS unsigned* st) {
    XcdBarrier b; b.bar = bar; b.x = xb_xcc_id(); b.st = st;
    if (threadIdx.x == 0) (void)xb_add(&bar[XB_XCNT(b.x)], 1u);
    return b;
}
__device__ __forceinline__ void xcd_barrier_complete(unsigned* bar, unsigned x, unsigned& nloc, unsigned& nx) {
    const unsigned G = gridDim.x * gridDim.y * gridDim.z;
    unsigned sum, cnt, mine, sp = 0u;
    for (;;) {
        sum = 0u; cnt = 0u; mine = 0u;
#pragma unroll
        for (unsigned j = 0; j < 16; ++j) { const unsigned c = xb_ld(&bar[XB_XCNT(j)]); sum += c; cnt += (c > 0u) ? 1u : 0u; mine = (j == x) ? c : mine; }
        if (sum == G) break;
        __builtin_amdgcn_s_sleep(1);
        if ((++sp & 255u) == 0u) { if (xb_ld(&bar[XB_TMO])) break; if (sp > XB_SPIN_CAP) { atomicAdd(&bar[XB_TMO], 1u); break; } }
    }
    nloc = mine > 0u ? mine : 1u; nx = cnt > 0u ? cnt : 1u;
}

__device__ __forceinline__ void xcd_barrier(const XcdBarrier& b) {
    asm volatile("s_waitcnt vmcnt(0)" ::: "memory");
    __syncthreads();
    if (threadIdx.x == 0) {
        unsigned* bar = b.bar;
        __builtin_amdgcn_s_waitcnt(0);
        unsigned nloc = b.st[0], nx = b.st[1];
        if (nloc == 0u) { xcd_barrier_complete(bar, b.x, nloc, nx); b.st[0] = nloc; b.st[1] = nx; }
        const unsigned old = xb_add(&bar[XB_XSUB(b.x)], 1u);
        const unsigned gen = old / nloc;
        if (old + 1u == (gen + 1u) * nloc) {
            __builtin_amdgcn_fence(__ATOMIC_RELEASE, "agent");
            asm volatile("s_waitcnt vmcnt(0)" ::: "memory");
            const unsigned og = xb_add(&bar[XB_TOP], 1u);
            const unsigned tg = og / nx;
            if (og + 1u == (tg + 1u) * nx) xb_add(&bar[XB_TOPGEN], 1u);
            else XB_SPIN(xb_ld(&bar[XB_TOPGEN]) == tg, bar);
            __builtin_amdgcn_fence(__ATOMIC_ACQUIRE, "agent");
            xb_add(&bar[XB_XGEN(b.x)], 1u);
            asm volatile("s_waitcnt vmcnt(0)" ::: "memory");
        } else {
            XB_SPIN(xb_ld(&bar[XB_XGEN(b.x)]) == gen, bar);
            __builtin_amdgcn_fence(__ATOMIC_ACQUIRE, "agent");
            asm volatile("s_waitcnt vmcnt(0)" ::: "memory");
        }
    }
    __syncthreads();
}

__device__ __forceinline__ float wave_sum(float v) {
#pragma unroll
    for (int o = 1; o < 64; o <<= 1) v += __shfl_xor(v, o);
    return v;
}
template <bool UPMAP = false>
__device__ __forceinline__ void transpose_item(const float* W, int K, int N, bf16* WT, int ldk, int row_off, LAS float* scr, int item, int lane, const float* kscale = nullptr) {
    const int nblk = N / 32, kb = item / nblk, nb = item % nblk, k0 = 64 * kb, n0 = 32 * nb;
    const int drow0 = UPMAP ? (n0 < DFF ? (n0 >> 7) * 256 + (n0 & 127) : ((n0 - DFF) >> 7) * 256 + 128 + ((n0 - DFF) & 127)) : row_off + n0;
    f32x4 wv[8]; const int kr = lane >> 3, nq = (lane & 7) * 4;
#pragma unroll
    for (int i = 0; i < 8; ++i) wv[i] = *(const GAS f32x4*)(W + (size_t)(k0 + 8 * i + kr) * N + n0 + nq);
#pragma unroll
    for (int i = 0; i < 8; ++i) { const int kk = 8 * i + kr; f32x4 w = wv[i]; if (kscale) w = w * kscale[k0 + kk];
        LAS float* d = scr + kk * 33 + nq; d[0] = w.x; d[1] = w.y; d[2] = w.z; d[3] = w.w; }
    LDS_WAIT(); asm volatile("" ::: "memory");
    const int c = lane & 7;
#pragma unroll
    for (int j = 0; j < 4; ++j) { const int n = (lane >> 3) + 8 * j; const LAS float* s = scr + (8 * c) * 33 + n;
        v4u o; o.x = pk2(s[0 * 33], s[1 * 33]); o.y = pk2(s[2 * 33], s[3 * 33]); o.z = pk2(s[4 * 33], s[5 * 33]); o.w = pk2(s[6 * 33], s[7 * 33]);
        *(GAS v4u*)(WT + (size_t)(drow0 + n) * ldk + k0 + 8 * c) = o; }
    LDS_WAIT(); asm volatile("" ::: "memory");
}
constexpr float W8SCALE = 64.0f;
__device__ __forceinline__ unsigned pk4_fp8(float a, float b, float c, float d) { unsigned w = 0u; w = __builtin_amdgcn_cvt_pk_fp8_f32(a, b, w, false); w = __builtin_amdgcn_cvt_pk_fp8_f32(c, d, w, true); return w; }
__device__ __forceinline__ void transpose_item_in(const float* W, bf16* WTu, unsigned char* WT8, LAS float* scr, int item, int lane) {
    constexpr int K = DM, N = INW;
    const int nblk = N / 32, kb = item / nblk, nb = item % nblk, k0 = 64 * kb, n0 = 32 * nb;
    f32x4 wv[8]; const int kr = lane >> 3, nq = (lane & 7) * 4;
#pragma unroll
    for (int i = 0; i < 8; ++i) wv[i] = *(const GAS f32x4*)(W + (size_t)(k0 + 8 * i + kr) * N + n0 + nq);
#pragma unroll
    for (int i = 0; i < 8; ++i) { const int kk = 8 * i + kr; const f32x4 w = wv[i]; LAS float* d = scr + kk * 33 + nq; d[0] = w.x; d[1] = w.y; d[2] = w.z; d[3] = w.w; }
    LDS_WAIT(); asm volatile("" ::: "memory");
    const int c = lane & 7;
    if (n0 >= 3072 && n0 < 5120) {
#pragma unroll
        for (int j = 0; j < 4; ++j) { const int n = (lane >> 3) + 8 * j; const LAS float* s = scr + (8 * c) * 33 + n;
            v4u o; o.x = pk2(s[0 * 33], s[1 * 33]); o.y = pk2(s[2 * 33], s[3 * 33]); o.z = pk2(s[4 * 33], s[5 * 33]); o.w = pk2(s[6 * 33], s[7 * 33]);
            *(GAS v4u*)(WTu + (size_t)(n0 - 3072 + n) * K + k0 + 8 * c) = o; }
    } else {
        const int r0 = n0 < 3072 ? n0 : n0 - 2048;
#pragma unroll
        for (int j = 0; j < 4; ++j) { const int n = (lane >> 3) + 8 * j; const LAS float* s = scr + (8 * c) * 33 + n;
            v2u o; o.x = pk4_fp8(s[0 * 33] * W8SCALE, s[1 * 33] * W8SCALE, s[2 * 33] * W8SCALE, s[3 * 33] * W8SCALE); o.y = pk4_fp8(s[4 * 33] * W8SCALE, s[5 * 33] * W8SCALE, s[6 * 33] * W8SCALE, s[7 * 33] * W8SCALE);
            *(GAS v2u*)(WT8 + (size_t)(r0 + n) * K + k0 + 8 * c) = o; }
    }
    LDS_WAIT(); asm volatile("" ::: "memory");
}
__device__ __forceinline__ void transpose_item_f8(const float* W, int K, int N, unsigned char* WT8, int ldk, LAS float* scr, int item, int lane) {
    const int nblk = N / 32, kb = item / nblk, nb = item % nblk, k0 = 64 * kb, n0 = 32 * nb;
    f32x4 wv[8]; const int kr = lane >> 3, nq = (lane & 7) * 4;
#pragma unroll
    for (int i = 0; i < 8; ++i) wv[i] = *(const GAS f32x4*)(W + (size_t)(k0 + 8 * i + kr) * N + n0 + nq);
#pragma unroll
    for (int i = 0; i < 8; ++i) { const int kk = 8 * i + kr; const f32x4 w = wv[i]; LAS float* d = scr + kk * 33 + nq; d[0] = w.x; d[1] = w.y; d[2] = w.z; d[3] = w.w; }
    LDS_WAIT(); asm volatile("" ::: "memory");
    const int c = lane & 7;
#pragma unroll
    for (int j = 0; j < 4; ++j) { const int n = (lane >> 3) + 8 * j; const LAS float* s = scr + (8 * c) * 33 + n;
        v2u o; o.x = pk4_fp8(s[0 * 33] * W8SCALE, s[1 * 33] * W8SCALE, s[2 * 33] * W8SCALE, s[3 * 33] * W8SCALE); o.y = pk4_fp8(s[4 * 33] * W8SCALE, s[5 * 33] * W8SCALE, s[6 * 33] * W8SCALE, s[7 * 33] * W8SCALE);
        *(GAS v2u*)(WT8 + (size_t)(n0 + n) * ldk + k0 + 8 * c) = o; }
    LDS_WAIT(); asm volatile("" ::: "memory");
}
__device__ __forceinline__ void rms_row_to_bf16(const float* xrow, const float* g, bf16* orow, int lane, unsigned char* o8row = nullptr) {
    const GAS f32x4* xr = (const GAS f32x4*)xrow + lane;
    f32x4 v[16]; float s = 0.f;
#pragma unroll
    for (int j = 0; j < 16; ++j) { v[j] = xr[64 * j]; s += (v[j].x * v[j].x + v[j].y * v[j].y) + (v[j].z * v[j].z + v[j].w * v[j].w); }
    const float inv = 1.0f / sqrtf(wave_sum(s) * (1.f / DM) + EPS);
    const GAS f32x4* gr = (const GAS f32x4*)g + lane;
    GAS v2u* o8 = (GAS v2u*)orow + lane;
#pragma unroll
    for (int j = 0; j < 16; ++j) { const f32x4 gg = gr[64 * j]; const float a = v[j].x * inv * gg.x, b = v[j].y * inv * gg.y, c = v[j].z * inv * gg.z, d = v[j].w * inv * gg.w;
        v2u w; w.x = pk2(a, b); w.y = pk2(c, d); o8[64 * j] = w;
        if (o8row) ((GAS unsigned*)o8row)[lane + 64 * j] = pk4_fp8(a, b, c, d); }
}
__device__ __forceinline__ void rms_row_bf16_to_f32(const bf16* hrow, const float* g, float* orow, int lane) {
    const GAS v4u* hr = (const GAS v4u*)hrow + lane;
    v4u v[8]; float s = 0.f;
#pragma unroll
    for (int j = 0; j < 8; ++j) { v[j] = hr[64 * j];
        const float a0 = bflo(v[j].x), a1 = bfhi(v[j].x), a2 = bflo(v[j].y), a3 = bfhi(v[j].y), a4 = bflo(v[j].z), a5 = bfhi(v[j].z), a6 = bflo(v[j].w), a7 = bfhi(v[j].w);
        s += ((a0 * a0 + a1 * a1) + (a2 * a2 + a3 * a3)) + ((a4 * a4 + a5 * a5) + (a6 * a6 + a7 * a7)); }
    const float inv = 1.0f / sqrtf(wave_sum(s) * (1.f / DM) + EPS);
#pragma unroll
    for (int j = 0; j < 8; ++j) { const int c = 512 * j + 8 * lane; const f32x4 g0 = *(const GAS f32x4*)(g + c), g1 = *(const GAS f32x4*)(g + c + 4);
        f32x4 o0, o1; o0.x = bflo(v[j].x) * inv * g0.x; o0.y = bfhi(v[j].x) * inv * g0.y; o0.z = bflo(v[j].y) * inv * g0.z; o0.w = bfhi(v[j].y) * inv * g0.w;
        o1.x = bflo(v[j].z) * inv * g1.x; o1.y = bfhi(v[j].z) * inv * g1.y; o1.z = bflo(v[j].w) * inv * g1.z; o1.w = bfhi(v[j].w) * inv * g1.w;
        *(GAS f32x4*)(orow + c) = o0; *(GAS f32x4*)(orow + c + 4) = o1; }
}
__device__ __forceinline__ void rms_row_inplace(float* xrow, const float* g, int lane) {
    GAS f32x4* xr = (GAS f32x4*)xrow + lane;
    f32x4 v[16]; float s = 0.f;
#pragma unroll
    for (int j = 0; j < 16; ++j) { v[j] = xr[64 * j]; s += (v[j].x * v[j].x + v[j].y * v[j].y) + (v[j].z * v[j].z + v[j].w * v[j].w); }
    const float inv = 1.0f / sqrtf(wave_sum(s) * (1.f / DM) + EPS);
    const GAS f32x4* gr = (const GAS f32x4*)g + lane;
#pragma unroll
    for (int j = 0; j < 16; ++j) { const f32x4 gg = gr[64 * j]; xr[64 * j] = v[j] * inv * gg; }
}
__device__ __forceinline__ void seq_pos(int m, int& t, int& S) { if (m < T_P) { t = m & (SEQ_P - 1); S = SEQ_P; } else { t = (m - T_P) & (SEQ_S - 1); S = SEQ_S; } }

template <int NB>
__device__ __forceinline__ void normrope_items(bf16* QB, bf16* KB, const float* qg, const float* kg, const f32x2* tab, int it0, int stride, int nitems, int lane, unsigned char* K8) {
    const int hh = lane >> 4, j = lane & 15, a = j >> 3, i0 = (j & 7) * 4;
    GAS v2u* p0[NB]; GAS v2u* p1[NB]; v2u w0[NB], w1[NB]; int tt[NB], mm[NB]; bool isq[NB], ok[NB];
#pragma unroll
    for (int b = 0; b < NB; ++b) { const int it = it0 + b * stride; ok[b] = it < nitems; const int itc = ok[b] ? it : it0; const int m = itc, s = 4; int t, S_; seq_pos(m, t, S_); tt[b] = t; mm[b] = m; isq[b] = s < 4;
        bf16* p4 = isq[b] ? QB + (size_t)m * NQ + s * 512 : KB + (size_t)m * NKV;
        p0[b] = (GAS v2u*)(p4 + hh * 128 + a * 64 + i0); p1[b] = (GAS v2u*)(p4 + hh * 128 + a * 64 + 32 + i0); w0[b] = *p0[b]; w1[b] = *p1[b]; }
#pragma unroll
    for (int b = 0; b < NB; ++b) {
        float x0[4] = {bflo(w0[b].x), bfhi(w0[b].x), bflo(w0[b].y), bfhi(w0[b].y)}, x1[4] = {bflo(w1[b].x), bfhi(w1[b].x), bflo(w1[b].y), bfhi(w1[b].y)};
        float ss = 0.f;
#pragma unroll
        for (int c = 0; c < 4; ++c) ss += x0[c] * x0[c] + x1[c] * x1[c];
        ss += __shfl_xor(ss, 1); ss += __shfl_xor(ss, 2); ss += __shfl_xor(ss, 4); ss += __shfl_xor(ss, 8);
        const float inv = 1.0f / sqrtf(ss * (1.f / 128.f) + EPS);
        const int pos = a == 0 ? (tt[b] >> 6) : (tt[b] & 63);
        const float* g = isq[b] ? qg : kg;
        const f32x4 g0 = *(const GAS f32x4*)(g + a * 64 + i0), g1 = *(const GAS f32x4*)(g + a * 64 + 32 + i0);
        float y0[4], y1[4];
#pragma unroll
        for (int c = 0; c < 4; ++c) { const f32x2 cs = tab[pos * 32 + i0 + c]; const float u0 = x0[c] * inv * g0[c], u1 = x1[c] * inv * g1[c]; y0[c] = u0 * cs.x - u1 * cs.y; y1[c] = u1 * cs.x + u0 * cs.y; }
        v2u o0, o1; o0.x = pk2(y0[0], y0[1]); o0.y = pk2(y0[2], y0[3]); o1.x = pk2(y1[0], y1[1]); o1.y = pk2(y1[2], y1[3]);
        if (ok[b]) {
            GAS unsigned char* kr = (GAS unsigned char*)K8 + (size_t)mm[b] * NKV + hh * 128 + a * 64 + ((i0 >> 3) & 1) * 32 + (i0 >> 4) * 8 + (i0 & 7);
            *(GAS unsigned*)kr = pk4_fp8(y0[0], y0[1], y0[2], y0[3]); *(GAS unsigned*)(kr + 16) = pk4_fp8(y1[0], y1[1], y1[2], y1[3]); }
    }
}
__device__ __forceinline__ void vt_block(const bf16* VB, unsigned char* VT8, int blk, int kvh, LAS unsigned char* scr, int lane) {
    const bf16* src = VB + (size_t)blk * 64 * NKV + kvh * 128;
    v4u x[16];
#pragma unroll
    for (int i = 0; i < 16; ++i) { const int ci = i * 64 + lane; x[i] = *(const GAS v4u*)(src + (size_t)(ci >> 4) * NKV + (ci & 15) * 8); }
#pragma unroll
    for (int i = 0; i < 16; ++i) { const int ci = i * 64 + lane, tok = ci >> 4, dch = ci & 15, s = tok >> 5, c = tok & 31, pos = ((c >> 2) & 1) * 32 + s * 16 + (c & 3) + 4 * (c >> 3);
        const unsigned w0 = __builtin_amdgcn_cvt_pk_fp8_f32(bflo(x[i].x), bfhi(x[i].x), 0, false), w1 = __builtin_amdgcn_cvt_pk_fp8_f32(bflo(x[i].y), bfhi(x[i].y), 0, false);
        const unsigned w2 = __builtin_amdgcn_cvt_pk_fp8_f32(bflo(x[i].z), bfhi(x[i].z), 0, false), w3 = __builtin_amdgcn_cvt_pk_fp8_f32(bflo(x[i].w), bfhi(x[i].w), 0, false);
        LAS unsigned char* d = scr + (dch * 8) * 64 + pos;
        d[0 * 64] = (unsigned char)w0; d[1 * 64] = (unsigned char)(w0 >> 8); d[2 * 64] = (unsigned char)w1; d[3 * 64] = (unsigned char)(w1 >> 8);
        d[4 * 64] = (unsigned char)w2; d[5 * 64] = (unsigned char)(w2 >> 8); d[6 * 64] = (unsigned char)w3; d[7 * 64] = (unsigned char)(w3 >> 8); }
    LDS_WAIT(); asm volatile("" ::: "memory");
    unsigned char* dst = VT8 + (size_t)(blk * 4 + kvh) * 8192;
#pragma unroll
    for (int i = 0; i < 8; ++i) *(GAS v4u*)(dst + (i * 64 + lane) * 16) = *(const LAS v4u*)(scr + (i * 64 + lane) * 16);
    LDS_WAIT(); asm volatile("" ::: "memory");
}
constexpr int PSEG = 32;
template <int W>
__device__ __forceinline__ void pool_seg(const bf16* u, bf16* d, int m0  , int grp, int lane) {
    int t0, S; seq_pos(m0, t0, S);
    const bf16* base = u + (size_t)(m0 - t0) * NU + grp * 512 + lane * 8;
    bf16* dbase = d + (size_t)(m0 - t0) * NU + grp * 512 + lane * 8;
    v4u ring[W]; float sum[8] = {0.f, 0.f, 0.f, 0.f, 0.f, 0.f, 0.f, 0.f};
    const v4u z = {0u, 0u, 0u, 0u};
#define POOL_ADD(vv_, sgn) do { const v4u q_ = (vv_); sum[0] += sgn bflo(q_.x); sum[1] += sgn bfhi(q_.x); sum[2] += sgn bflo(q_.y); sum[3] += sgn bfhi(q_.y); sum[4] += sgn bflo(q_.z); sum[5] += sgn bfhi(q_.z); sum[6] += sgn bflo(q_.w); sum[7] += sgn bfhi(q_.w); } while (0)
#pragma unroll
    for (int i = 0; i < W - 1; ++i) { const int r = t0 - W / 2 + i; const v4u x = (r >= 0 && r < S) ? *(const GAS v4u*)(base + (size_t)r * NU) : z; ring[(W - W / 2 + i) % W] = x; }
#pragma unroll
    for (int i = 0; i < W - 1; ++i) POOL_ADD(ring[(W - W / 2 + i) % W], +);
    ring[(W / 2 - 1) % W] = z;
#pragma unroll 1
    for (int b = 0; b < PSEG; b += 16) {
        v4u nw[16];
#pragma unroll
        for (int s = 0; s < 16; ++s) { const int r = t0 + b + s + W / 2 - 1; nw[s] = (r >= 0 && r < S) ? *(const GAS v4u*)(base + (size_t)r * NU) : z; }
#pragma unroll
        for (int s = 0; s < 16; ++s) { const int t = t0 + b + s;
            const int slot = (s + W / 2 - 1) % W;
            POOL_ADD(ring[slot], -); ring[slot] = nw[s]; POOL_ADD(nw[s], +);
            const int lo = t - W / 2 < 0 ? 0 : t - W / 2, hi = t + W / 2 > S ? S : t + W / 2; const float rc = 1.0f / (float)(hi - lo);
            const v4u c = ring[s % W];
            v4u o; o.x = pk2(sum[0] * rc - bflo(c.x), sum[1] * rc - bfhi(c.x)); o.y = pk2(sum[2] * rc - bflo(c.y), sum[3] * rc - bfhi(c.y));
            o.z = pk2(sum[4] * rc - bflo(c.z), sum[5] * rc - bfhi(c.z)); o.w = pk2(sum[6] * rc - bflo(c.w), sum[7] * rc - bfhi(c.w));
            *(GAS v4u*)(dbase + (size_t)t * NU) = o; }
    }
#undef POOL_ADD
}
__device__ __forceinline__ float silu_f(float x) { return x * __builtin_amdgcn_rcpf(1.0f + __builtin_amdgcn_exp2f(-1.4426950408889634f * x)); }
__device__ __forceinline__ void fixup_item(const float* hb, bf16* act, const float* cw, const float* cb, int pm, int which, int colg, int lane) {
    const int j0 = colg * 512 + lane * 8;
    if (j0 >= DFF) return;
    const int row = pm * 256 + (which ? 255 : 0); int t, S; seq_pos(row, t, S);
    const size_t tc = (size_t)(j0 >> 7) * 256 + (j0 & 127);
    const float* hp = which ? hb + ((size_t)pm * 4 + 2) * NUP : (t > 0 ? hb + ((size_t)(pm - 1) * 4 + 3) * NUP : nullptr);
    const float* hc = hb + ((size_t)pm * 4 + (which ? 3 : 0)) * NUP;
    const float* hn = which ? (t < S - 1 ? hb + ((size_t)(pm + 1) * 4 + 0) * NUP : nullptr) : hb + ((size_t)pm * 4 + 1) * NUP;
    float o[8];
#pragma unroll
    for (int q = 0; q < 2; ++q) {
        const int j = j0 + 4 * q; const size_t p = tc + 4 * q; const f32x4 z = {0.f, 0.f, 0.f, 0.f};
        const f32x4 gp = hp ? *(const GAS f32x4*)(hp + p) : z, vp = hp ? *(const GAS f32x4*)(hp + p + 128) : z;
        const f32x4 gc = *(const GAS f32x4*)(hc + p), vc = *(const GAS f32x4*)(hc + p + 128);
        const f32x4 gn = hn ? *(const GAS f32x4*)(hn + p) : z, vn = hn ? *(const GAS f32x4*)(hn + p + 128) : z;
        const f32x4 w0g = *(const GAS f32x4*)(cw + j), w1g = *(const GAS f32x4*)(cw + NUP + j), w2g = *(const GAS f32x4*)(cw + 2 * (size_t)NUP + j), bg = *(const GAS f32x4*)(cb + j);
        const f32x4 w0v = *(const GAS f32x4*)(cw + DFF + j), w1v = *(const GAS f32x4*)(cw + NUP + DFF + j), w2v = *(const GAS f32x4*)(cw + 2 * (size_t)NUP + DFF + j), bv = *(const GAS f32x4*)(cb + DFF + j);
#pragma unroll
        for (int e = 0; e < 4; ++e) { const float cg = bg[e] + w0g[e] * gp[e] + w1g[e] * gc[e] + w2g[e] * gn[e], cv = bv[e] + w0v[e] * vp[e] + w1v[e] * vc[e] + w2v[e] * vn[e]; o[4 * q + e] = silu_f(cg) * cv; }
    }
    v4u w; w.x = pk2(o[0], o[1]); w.y = pk2(o[2], o[3]); w.z = pk2(o[4], o[5]); w.w = pk2(o[6], o[7]);
    *(GAS v4u*)(act + (size_t)row * DFF + j0) = w;
}

struct Args { const float* in[16]; float* out; unsigned char* ws; };
template <int OFF> __device__ __forceinline__ unsigned long long karg_u64() {
    auto kp = __builtin_amdgcn_kernarg_segment_ptr(); unsigned long long v;
    asm volatile("s_load_dwordx2 %0, %1, %2\n\ts_waitcnt lgkmcnt(0)" : "=s"(v) : "s"(kp), "i"(OFF) : "memory"); return v;
}
#define KIN(i) ((const float*)karg_u64<8 * (i)>())
#define KOUT() ((float*)karg_u64<128>())
#define KWS() ((unsigned char*)karg_u64<136>())
__global__ void __launch_bounds__(NWAVES * 64, 2) fwd_kernel(Args args) {
    extern __shared__ __attribute__((aligned(16))) unsigned char lds[];
    LAS unsigned char* L = (LAS unsigned char*)lds;
    const int G = gridDim.x, bx = blockIdx.x;
    for (int u = threadIdx.x; u < (LDS_BYTES - LDSCTL_OFF) / 4; u += NWAVES * 64) ((LAS unsigned*)(L + LDSCTL_OFF))[u] = 0u;
    __syncthreads();
    XcdBarrier bar = xcd_barrier_post((unsigned*)(KWS() + WS_CTL) + CW_BAR, (volatile LAS unsigned*)(L + MISC_OFF) + 8);
#define GRID_BAR() xcd_barrier(bar)
#ifndef PH_MASK
#define PH_MASK 0xFFFF
#endif
#define PH(k) constexpr ((PH_MASK >> (k)) & 1)
#define TVIEW() int tid = threadIdx.x; asm volatile("" : "+v"(tid)); const int lane = tid & 63, wave = __builtin_amdgcn_readfirstlane(tid >> 6); \
    const int vcu = (G % 8 == 0) ? (bx % 8) * (G / 8) + bx / 8 : bx, gw = vcu * NWAVES + wave, NGW = G * NWAVES; (void)lane; (void)gw; (void)NGW; \
    unsigned char* ws = KWS(); (void)ws

    if PH(0)
    {
        TVIEW();
        LAS float* scr = (LAS float*)(L + RING_OFF + wave * 16384);
        constexpr int I_IN = (DM / 64) * (INW / 32), I_ATT = (NQ / 64) * (DM / 32), I_POOL = (512 / 64) * (1024 / 32), I_OUT = (DM / 64) * (DM / 32), I_UP = (DM / 64) * (NUP / 32);
        constexpr int I_DOWN = (DFF / 64) * (DM / 32), I_DOWN_P0 = I_DOWN - I_DOWN_TAIL;
        constexpr int NITEMS = I_IN + I_ATT + 4 * I_POOL + I_OUT + I_UP + I_DOWN_P0;
        for (int it = gw; it < NITEMS; it += NGW) {
            int r = it;
            if (r < I_IN) { transpose_item_in(KIN(3), (bf16*)(ws + WS_WIN), ws + WS_WIN8, scr, r, lane); continue; } r -= I_IN;
            if (r < I_ATT) { transpose_item_f8(KIN(6), NQ, DM, ws + WS_WATT, NQ, scr, r, lane); continue; } r -= I_ATT;
            if (r < 4 * I_POOL) { const int g = r / I_POOL; transpose_item(KIN(7) + (size_t)g * 512 * 1024, 512, 1024, (bf16*)(ws + WS_WPOOL), 512, g * 1024, scr, r % I_POOL, lane); continue; } r -= 4 * I_POOL;
            if (r < I_OUT) { transpose_item(KIN(9), DM, DM, (bf16*)(ws + WS_WOUT), DM, 0, scr, r, lane); continue; } r -= I_OUT;
            if (r < I_UP) { transpose_item<true>(KIN(11), DM, NUP, (bf16*)(ws + WS_WUP), DM, 0, scr, r, lane, KIN(10)); continue; } r -= I_UP;
            transpose_item(KIN(14), DFF, DM, (bf16*)KOUT(), DFF, 0, scr, I_DOWN_TAIL + r, lane);
        }
        f32x2* rope = (f32x2*)(ws + WS_ROPE);
        for (int e = bx * (NWAVES * 64) + tid; e < 64 * 32; e += G * NWAVES * 64) {
            const int pos = e >> 5, i = e & 31; const float inv_freq = exp2f(-(float)i * (13.287712379549449f / 32.0f)); const float ang = (float)pos * inv_freq;
            f32x2 cs; cs.x = cosf(ang); cs.y = sinf(ang); rope[e] = cs; }
        const float* xp = KIN(0); const float* xs = KIN(1); const float* g_mix = KIN(2); bf16* NB = (bf16*)(ws + WS_R1);
        for (int m = gw; m < T_ALL; m += NGW) rms_row_to_bf16(m < T_P ? xp + (size_t)m * DM : xs + (size_t)(m - T_P) * DM, g_mix, NB + (size_t)m * DM, lane, (unsigned char*)KOUT() + N8_OFF + (size_t)m * DM);
    }
    GRID_BAR();
    if PH(1)
    {
        unsigned char* ws = KWS();
        {
            pg8::Gemm g{(bf16*)(ws + WS_R1), (bf16*)(ws + WS_WIN), DM, DM, DM, 0, 0u}; pg8::StaticOrder S; S.init(T_ALL, NU, G, bx);
            pg8::EpiBf16 E{(bf16*)(ws + WS_U), NU};
            pg8::gemm_phase<pg8::EpiBf16, pg8::StaticOrder, true, true>(L + RING_OFF, g, S, E);
        }
        {
            pg8::Gemm g{(bf16*)((unsigned char*)KOUT() + N8_OFF), (bf16*)(ws + WS_WIN8), DM / 2, DM / 2, DM / 2, 0, 0u}; pg8::StaticOrder S; S.init(T_ALL, INW - NU, G, bx);
            pg8::EpiProj8 E{(bf16*)(ws + WS_Q), (bf16*)(ws + WS_K), (bf16*)(ws + WS_V), (bf16*)(ws + WS_SA), (bf16*)(ws + WS_SP), 1.0f / W8SCALE};
            pg8::gemm_phase<pg8::EpiProj8, pg8::StaticOrder, true, true, true>(L + RING_OFF, g, S, E);
        }
        { constexpr int NWG = (T_ALL / 256) * ((INW - NU) / 256), I_DOWN = (DFF / 64) * (DM / 32);
          const int rem = NWG % G, nh = rem ? G - rem : G, hidx = rem ? bx - rem : bx;
          if (hidx >= 0) { TVIEW(); LAS float* scr = (LAS float*)(L + RING_OFF + wave * 16384); const float* w_down = KIN(14); bf16* WD = (bf16*)KOUT();
              for (int it = hidx * NWAVES + wave; it < I_DOWN_TAIL; it += nh * NWAVES) transpose_item(w_down, DFF, DM, WD, DFF, 0, scr, it, lane); } }
    }
    GRID_BAR();
    if PH(2)
    {
        TVIEW();
        LAS float* scr = (LAS float*)(L + RING_OFF + wave * 16384);
        { const float* qg = KIN(4); const float* kg = KIN(5); const f32x2* rope = (const f32x2*)(ws + WS_ROPE); bf16* QB = (bf16*)(ws + WS_Q); bf16* KB = (bf16*)(ws + WS_K);
          for (int it = gw; it < T_ALL; it += 4 * NGW) normrope_items<4>(QB, KB, qg, kg, rope, it, NGW, T_ALL, lane, ws + WS_K8); }
        { const bf16* VB = (const bf16*)(ws + WS_V); LAS unsigned char* scr8 = L + RING_OFF + wave * 16384;
          for (int it = gw; it < (T_ALL / 64) * 4; it += NGW) vt_block(VB, ws + WS_VT8, it >> 2, it & 3, scr8, lane); }
        { const bf16* UB = (const bf16*)(ws + WS_U); bf16* DB = (bf16*)(ws + WS_D);
          for (int it = gw; it < (T_ALL / PSEG) * 4; it += NGW) { const int m0 = (it >> 2) * PSEG, gr = it & 3;
              if (gr == 0) pool_seg<2>(UB, DB, m0, 0, lane); else if (gr == 1) pool_seg<4>(UB, DB, m0, 1, lane); else if (gr == 2) pool_seg<8>(UB, DB, m0, 2, lane); else pool_seg<16>(UB, DB, m0, 3, lane); } }
    }
    GRID_BAR();
    if PH(3)
    {
        unsigned char* ws = KWS();
        const bf16* QB = (const bf16*)(ws + WS_Q); const bf16* KB = (const bf16*)(ws + WS_K); const bf16* VB = (const bf16*)(ws + WS_V); unsigned char* OB = ws + WS_O;
        const float* qg = KIN(4); const float* rope = (const float*)(ws + WS_ROPE);
        for (int s = bx; s < 6 * 256; s += G) {
            const int r = s >> 8, c = s & 255, xcd = c & 7, idx = c >> 3;
            int b, kvh, h, qb, S_, row0;
            if (r < 4) { const int grp = 4 * xcd + r; b = grp >> 2; kvh = grp & 3; h = kvh * 4 + (idx >> 3); qb = idx & 7; S_ = SEQ_P; row0 = b * SEQ_P; }
            else { b = xcd >> 2; kvh = xcd & 3; const int un = idx + 32 * (r - 4); h = kvh * 4 + (un >> 4); qb = un & 15; S_ = SEQ_S; row0 = T_P + b * SEQ_S; }
            att::attn_unit8(QB + (size_t)(row0 + qb * 256) * NQ + h * 128, ws + WS_K8 + (size_t)row0 * NKV + kvh * 128, ws + WS_VT8 + (size_t)((row0 >> 6) * 4 + kvh) * 8192,
                            OB + (size_t)(row0 + qb * 256) * NQ + h * 128, S_, (LAS char*)(L + RING_OFF), qg, rope, qb * 256);
        }
    }
    GRID_BAR();
    if PH(4)
    {
        unsigned char* ws = KWS();
        pg8::Gemm g{(bf16*)(ws + WS_D), (bf16*)(ws + WS_WPOOL), NU, 512, 512, 2, 1024u}; pg8::StaticOrder S; S.init(T_ALL, DM, G, bx);
        pg8::EpiPool E{(bf16*)(ws + WS_SP), KIN(8)};
        pg8::gemm_phase<pg8::EpiPool, pg8::StaticOrder, false, true>(L + RING_OFF, g, S, E);
    }
    if PH(5)
    {
        unsigned char* ws = KWS();
        pg8::Gemm g{(bf16*)(ws + WS_O), (bf16*)(ws + WS_WATT), NQ / 2, NQ / 2, NQ / 2, 0, 0u}; pg8::StaticOrder S; S.init(T_ALL, DM, G, bx);
        pg8::EpiMerge E{(bf16*)(ws + WS_SA), (const bf16*)(ws + WS_SP), 1.0f / (W8SCALE * att::O8SCALE)};
        pg8::gemm_phase<pg8::EpiMerge, pg8::StaticOrder, false, true, true>(L + RING_OFF, g, S, E);
    }
    GRID_BAR();
    if PH(6)
    {
        unsigned char* ws = KWS();
        pg8::Gemm g{(bf16*)(ws + WS_SA), (bf16*)(ws + WS_WOUT), DM, DM, DM, 0, 0u}; pg8::StaticOrder S; S.init(T_ALL, DM, G, bx);
        pg8::EpiResNorm E{KIN(0), KIN(1), T_P / 256, (bf16*)(ws + WS_R1), (float*)(ws + WS_CTL + CTL_SSQ1)};
        pg8::gemm_phase<pg8::EpiResNorm, pg8::StaticOrder, false, true>(L + RING_OFF, g, S, E);
    }
    GRID_BAR();
    if PH(8)
    {
        unsigned char* ws = KWS();
        pg8::Gemm g{(bf16*)(ws + WS_R1), (bf16*)(ws + WS_WUP), DM, DM, DM, 0, 0u}; pg8::StaticOrder S; S.init(T_ALL, NUP, G, bx);
        pg8::EpiConvGlu E{(bf16*)(ws + WS_ACT), (float*)(ws + WS_HB), KIN(12), KIN(13), DFF, NUP, (const float*)(ws + WS_CTL + CTL_SSQ1), 1.0f / DM, EPS};
        S.lim = (S.nwg / G) * G;
        pg8::gemm_phase<pg8::EpiConvGlu, pg8::StaticOrder, true, true>(L + RING_OFF, g, S, E);
        if (G == 256 && S.nwg - S.lim == 64) {
            const int j = bx >> 3, kp = j & 3, slot = (j >> 2) * 8 + (bx & 7);
            pg8::Gemm g2{(bf16*)(ws + WS_R1) + kp * (DM / 4), (bf16*)(ws + WS_WUP) + kp * (DM / 4), DM, DM, DM / 4, 0, 0u};
            pg8::StaticOrder S2; S2.init(T_ALL, NUP, S.nwg, S.lim + slot);
            pg8::EpiConvGluTail E2{E, (float*)(ws + WS_WIN), (unsigned*)(ws + WS_CTL + CTL_TAILF), bar.bar, kp, slot};
            pg8::gemm_phase<pg8::EpiConvGluTail, pg8::StaticOrder, true, true>(L + RING_OFF, g2, S2, E2);
        } else {
            pg8::StaticOrder S2; S2.init(T_ALL, NUP, S.nwg, S.lim + bx); if (bx >= S.nwg - S.lim) S2.lim = 0;
            pg8::gemm_phase<pg8::EpiConvGlu, pg8::StaticOrder, true, true>(L + RING_OFF, g, S2, E);
        }
    }
    GRID_BAR();
    if PH(8)
    {
        TVIEW();
        const float* HB = (const float*)(ws + WS_HB); bf16* ACT = (bf16*)(ws + WS_ACT); const float* conv_w = KIN(12); const float* conv_b = KIN(13);
        for (int it = gw; it < 96 * 2 * 22; it += NGW) fixup_item(HB, ACT, conv_w, conv_b, it / 44, (it % 44) / 22, it % 22, lane);
    }
    GRID_BAR();
    if PH(8)
    {
        unsigned char* ws = KWS();
        pg8::Gemm g{(bf16*)(ws + WS_ACT), (bf16*)KOUT(), DFF, DFF, DFF, 0, 0u}; pg8::StaticOrder S; S.init(T_ALL, DM, G, bx);
        pg8::EpiResBf16 E{(bf16*)(ws + WS_R1)};
        pg8::gemm_phase<pg8::EpiResBf16, pg8::StaticOrder, false, true>(L + RING_OFF, g, S, E);
    }
    GRID_BAR();
    if PH(9)
    {
        TVIEW();
        float* out = KOUT(); const float* g_fin = KIN(15);
        const bf16* H2 = (const bf16*)(ws + WS_R1);
        for (int m = gw; m < T_ALL; m += NGW) rms_row_bf16_to_f32(H2 + (size_t)m * DM, g_fin, out + (size_t)m * DM, lane);
    }
}

extern "C" void kernel_launch(void* const* d_in, const int* in_sizes, int n_in, void* d_out, int out_size, void* d_ws, size_t ws_size, hipStream_t stream) {
    static int grid = 0;
    if (grid == 0) {
        if (n_in != 16 || out_size != T_ALL * DM || ws_size < WS_END) { fprintf(stderr, "kernel_launch: unexpected shapes (n_in %d out %d ws %zu need %zu); nothing launched\n", n_in, out_size, ws_size, (size_t)WS_END); grid = -1; return; }
        int dev = 0, cus = 0, per_cu = 0;
        if (hipGetDevice(&dev) != hipSuccess || hipDeviceGetAttribute(&cus, hipDeviceAttributeMultiprocessorCount, dev) != hipSuccess) { grid = -1; return; }
        if (hipFuncSetAttribute((const void*)fwd_kernel, hipFuncAttributeMaxDynamicSharedMemorySize, LDS_BYTES) != hipSuccess) { fprintf(stderr, "kernel_launch: hipFuncSetAttribute failed\n"); grid = -1; return; }
        if (hipOccupancyMaxActiveBlocksPerMultiprocessor(&per_cu, (const void*)fwd_kernel, NWAVES * 64, LDS_BYTES) != hipSuccess || per_cu < 1) { fprintf(stderr, "kernel_launch: occupancy query reports %d\n", per_cu); }
        (void)hipGetLastError();
        grid = cus;
    }
    if (grid < 0) return;
    if (hipMemsetAsync((char*)d_ws + WS_CTL, 0, CTL_ZERO_BYTES, stream) != hipSuccess) return;
    Args a{};
    for (int i = 0; i < 16; ++i) a.in[i] = (const float*)d_in[i];
    a.out = (float*)d_out; a.ws = (unsigned char*)d_ws;
    hipLaunchKernelGGL(fwd_kernel, dim3(grid), dim3(NWAVES * 64), LDS_BYTES, stream, a);
}
```

```cpp
#include <hip/hip_runtime.h>
#include <cstdio>
#include <cstdint>
namespace pg8 {
#define PG8_LAS __attribute__((address_space(3)))
#define PG8_GAS __attribute__((address_space(1)))
typedef unsigned short bf16_t;
typedef short bf16x8 __attribute__((ext_vector_type(8)));
typedef float f32x4 __attribute__((ext_vector_type(4)));
typedef unsigned u32x4 __attribute__((ext_vector_type(4)));
constexpr int BM = 256, BK = 64, HALF = 128, HTB = HALF * BK * 2  , STAGE_BYTES = 8 * HTB, NXCD = 8, WGM = 4;
constexpr int XL_OFF = STAGE_BYTES + 1024;

__host__ __device__ __forceinline__ int lds_byte(int r, int c) { const int st = (r >> 4) * 2 + (c >> 5), rr = r & 15, cc = c & 31, ob = rr * 64 + cc * 2; return st * 1024 + (ob ^ (((ob >> 9) & 1) << 5)); }
__host__ __device__ __forceinline__ void stage_rc(int b, int& R, int& C) { const int st = b / 1024, sb = b % 1024, swz = sb ^ (((sb >> 9) & 1) << 5); R = (st >> 1) * 16 + swz / 64; C = (st & 1) * 32 + (swz % 64) / 2; }
__host__ __device__ __forceinline__ int perm32(int rho) { const int n = rho >> 4, i = rho & 15; return 8 * (i >> 2) + 4 * n + (i & 3); }

struct Unit { int pm, pn; };
struct Gemm { const bf16_t* A; const bf16_t* Bt; int lda, ldb, K; int gshift; unsigned goff; };

struct StaticOrder {
    int nM, nN, nwg, G, c, lim;
    __host__ __device__ void init(int M, int N, int G_, int c_) { nM = M / BM; nN = N / BM; nwg = nM * nN; G = G_; c = c_; lim = nwg; }
    __host__ __device__ bool next(int i, Unit& u) const {
        const long L = (long)i * G + c; if (L >= lim) return false;
        int wgid = (int)L; { const int q = nwg / NXCD, r = nwg % NXCD, xcd = wgid % NXCD, off = wgid / NXCD; wgid = (xcd < r ? xcd * (q + 1) : r * (q + 1) + (xcd - r) * q) + off; }
        const int nig = WGM * nN, gid = wgid / nig, fm = gid * WGM, gsz = (nM - fm) < WGM ? (nM - fm) : WGM;
        u.pm = fm + ((wgid % nig) % gsz); u.pn = (wgid % nig) / gsz; return true;
    }
    __device__ __forceinline__ void a_ready(const Unit&) const {}
    __device__ __forceinline__ void done(const Unit&) const {}
};


typedef float f32x2c __attribute__((ext_vector_type(2)));
typedef __bf16 bf16x2c __attribute__((ext_vector_type(2)));
__device__ __forceinline__ unsigned cvt_pk_bf16(float lo, float hi) { const f32x2c v = {lo, hi}; return __builtin_bit_cast(unsigned, __builtin_convertvector(v, bf16x2c)); }
__device__ __forceinline__ float bf_lo(unsigned w) { return __uint_as_float(w << 16); }
__device__ __forceinline__ float bf_hi(unsigned w) { return __uint_as_float(w & 0xffff0000u); }
__device__ __forceinline__ float sigmoidf_fast(float x) { return __builtin_amdgcn_rcpf(1.0f + __builtin_amdgcn_exp2f(-1.4426950408889634f * x)); }

struct EpiBf16 {
    static constexpr bool PERM = true, AFTER_DRAIN = false, USES_LDS = false;
    bf16_t* O; int ldc;
    __device__ __forceinline__ void operator()(const f32x4 (&acc)[2][2][4][2], const Unit& u, int wr, int wc, int fr, int fq) const {
        const int row0 = u.pm * BM + wr * 64 + fr, col0 = u.pn * BM + wc * 32 + 8 * fq;
#pragma unroll
        for (int ai = 0; ai < 2; ++ai)
#pragma unroll
            for (int m = 0; m < 4; ++m) { bf16_t* rowp = O + (size_t)(row0 + ai * HALF + m * 16) * ldc + col0;
#pragma unroll
                for (int bj = 0; bj < 2; ++bj) { const f32x4 v0 = acc[ai][bj][m][0], v1 = acc[ai][bj][m][1];
                    u32x4 w; w.x = cvt_pk_bf16(v0[0], v0[1]); w.y = cvt_pk_bf16(v0[2], v0[3]); w.z = cvt_pk_bf16(v1[0], v1[1]); w.w = cvt_pk_bf16(v1[2], v1[3]);
                    *(u32x4*)(rowp + bj * HALF) = w; } }
    }
};
struct EpiProj {
    static constexpr bool PERM = true, AFTER_DRAIN = false, USES_LDS = false;
    bf16_t *q, *k, *v, *u, *sa, *sp;
    __device__ __forceinline__ void operator()(const f32x4 (&acc)[2][2][4][2], const Unit& un, int wr, int wc, int fr, int fq) const {
        const int pn = un.pn; bf16_t* base; int ldc, ct; bool sg = false;
        if (pn < 8) { base = q; ldc = 2048; ct = pn; } else if (pn < 10) { base = k; ldc = 512; ct = pn - 8; } else if (pn < 12) { base = v; ldc = 512; ct = pn - 10; }
        else if (pn < 20) { base = u; ldc = 2048; ct = pn - 12; } else if (pn < 36) { base = sa; ldc = 4096; ct = pn - 20; sg = true; } else { base = sp; ldc = 4096; ct = pn - 36; sg = true; }
        const int row0 = un.pm * BM + wr * 64 + fr, col0 = ct * BM + wc * 32 + 8 * fq;
#pragma unroll
        for (int ai = 0; ai < 2; ++ai)
#pragma unroll
            for (int m = 0; m < 4; ++m) { bf16_t* rowp = base + (size_t)(row0 + ai * HALF + m * 16) * ldc + col0;
#pragma unroll
                for (int bj = 0; bj < 2; ++bj) { f32x4 v0 = acc[ai][bj][m][0], v1 = acc[ai][bj][m][1];
                    if (sg) {
#pragma unroll
                        for (int e = 0; e < 4; ++e) { v0[e] = sigmoidf_fast(v0[e]); v1[e] = sigmoidf_fast(v1[e]); } }
                    u32x4 w; w.x = cvt_pk_bf16(v0[0], v0[1]); w.y = cvt_pk_bf16(v0[2], v0[3]); w.z = cvt_pk_bf16(v1[0], v1[1]); w.w = cvt_pk_bf16(v1[2], v1[3]);
                    *(u32x4*)(rowp + bj * HALF) = w; } }
    }
};
struct EpiProj8 {
    static constexpr bool PERM = true, AFTER_DRAIN = false, USES_LDS = false;
    static constexpr int F8_SB = 124;
    bf16_t *q, *k, *v, *sa, *sp; float scale;
    __device__ __forceinline__ void operator()(const f32x4 (&acc)[2][2][4][2], const Unit& un, int wr, int wc, int fr, int fq) const {
        const int pn = un.pn; bf16_t* base; int ldc, ct; bool sg = false;
        if (pn < 8) { base = q; ldc = 2048; ct = pn; } else if (pn < 10) { base = k; ldc = 512; ct = pn - 8; } else if (pn < 12) { base = v; ldc = 512; ct = pn - 10; }
        else if (pn < 28) { base = sa; ldc = 4096; ct = pn - 12; sg = true; } else { base = sp; ldc = 4096; ct = pn - 28; sg = true; }
        const int row0 = un.pm * BM + wr * 64 + fr, col0 = ct * BM + wc * 32 + 8 * fq;
#pragma unroll
        for (int ai = 0; ai < 2; ++ai)
#pragma unroll
            for (int m = 0; m < 4; ++m) { bf16_t* rowp = base + (size_t)(row0 + ai * HALF + m * 16) * ldc + col0;
#pragma unroll
                for (int bj = 0; bj < 2; ++bj) { f32x4 v0 = acc[ai][bj][m][0], v1 = acc[ai][bj][m][1];
                    if (sg) {
#pragma unroll
                        for (int e = 0; e < 4; ++e) { v0[e] = sigmoidf_fast(v0[e]); v1[e] = sigmoidf_fast(v1[e]); } }
                    u32x4 w; w.x = cvt_pk_bf16(v0[0], v0[1]); w.y = cvt_pk_bf16(v0[2], v0[3]); w.z = cvt_pk_bf16(v1[0], v1[1]); w.w = cvt_pk_bf16(v1[2], v1[3]);
                    *(PG8_GAS u32x4*)(rowp + bj * HALF) = w; } }
    }
};
struct EpiPool {
    static constexpr bool PERM = true, AFTER_DRAIN = false, USES_LDS = false;
    bf16_t* sp; const float* ps;
    __device__ __forceinline__ void operator()(const f32x4 (&acc)[2][2][4][2], const Unit& un, int wr, int wc, int fr, int fq) const {
        const int row0 = un.pm * BM + wr * 64 + fr, col0 = un.pn * BM + wc * 32 + 8 * fq;
        f32x4 sc[2][2];
#pragma unroll
        for (int bj = 0; bj < 2; ++bj)
#pragma unroll
            for (int n = 0; n < 2; ++n) sc[bj][n] = *(const PG8_GAS f32x4*)(ps + col0 + bj * HALF + 4 * n);
#pragma unroll
        for (int ai = 0; ai < 2; ++ai) {
            u32x4 gg[4][2];
#pragma unroll
            for (int m = 0; m < 4; ++m)
#pragma unroll
                for (int bj = 0; bj < 2; ++bj) gg[m][bj] = *(const PG8_GAS u32x4*)(sp + (size_t)(row0 + ai * HALF + m * 16) * 4096 + col0 + bj * HALF);
            asm volatile("" ::: "memory");
#pragma unroll
            for (int m = 0; m < 4; ++m)
#pragma unroll
                for (int bj = 0; bj < 2; ++bj) { const u32x4 g = gg[m][bj];
                    const f32x4 v0 = acc[ai][bj][m][0] * sc[bj][0], v1 = acc[ai][bj][m][1] * sc[bj][1];
                    u32x4 w; w.x = cvt_pk_bf16(v0[0] * bf_lo(g.x), v0[1] * bf_hi(g.x)); w.y = cvt_pk_bf16(v0[2] * bf_lo(g.y), v0[3] * bf_hi(g.y));
                    w.z = cvt_pk_bf16(v1[0] * bf_lo(g.z), v1[1] * bf_hi(g.z)); w.w = cvt_pk_bf16(v1[2] * bf_lo(g.w), v1[3] * bf_hi(g.w));
                    *(PG8_GAS u32x4*)(sp + (size_t)(row0 + ai * HALF + m * 16) * 4096 + col0 + bj * HALF) = w; }
        }
    }
};
struct EpiMerge {
    static constexpr bool PERM = true, AFTER_DRAIN = false, USES_LDS = false;
    static constexpr int F8_SB = 122;
    bf16_t* sa; const bf16_t* P; float scale;
    __device__ __forceinline__ void operator()(const f32x4 (&acc)[2][2][4][2], const Unit& un, int wr, int wc, int fr, int fq) const {
        const int row0 = un.pm * BM + wr * 64 + fr, col0 = un.pn * BM + wc * 32 + 8 * fq;
#pragma unroll
        for (int ai = 0; ai < 2; ++ai) {
            u32x4 gg[4][2], pp[4][2];
#pragma unroll
            for (int m = 0; m < 4; ++m)
#pragma unroll
                for (int bj = 0; bj < 2; ++bj) { const size_t off = (size_t)(row0 + ai * HALF + m * 16) * 4096 + col0 + bj * HALF; gg[m][bj] = *(const PG8_GAS u32x4*)(sa + off); pp[m][bj] = *(const PG8_GAS u32x4*)(P + off); }
            asm volatile("" ::: "memory");
#pragma unroll
            for (int m = 0; m < 4; ++m)
#pragma unroll
                for (int bj = 0; bj < 2; ++bj) { const u32x4 g = gg[m][bj], p = pp[m][bj]; const f32x4 v0 = acc[ai][bj][m][0], v1 = acc[ai][bj][m][1];
                    u32x4 w; w.x = cvt_pk_bf16(v0[0] * bf_lo(g.x) + bf_lo(p.x), v0[1] * bf_hi(g.x) + bf_hi(p.x)); w.y = cvt_pk_bf16(v0[2] * bf_lo(g.y) + bf_lo(p.y), v0[3] * bf_hi(g.y) + bf_hi(p.y));
                    w.z = cvt_pk_bf16(v1[0] * bf_lo(g.z) + bf_lo(p.z), v1[1] * bf_hi(g.z) + bf_hi(p.z)); w.w = cvt_pk_bf16(v1[2] * bf_lo(g.w) + bf_lo(p.w), v1[3] * bf_hi(g.w) + bf_hi(p.w));
                    *(PG8_GAS u32x4*)(sa + (size_t)(row0 + ai * HALF + m * 16) * 4096 + col0 + bj * HALF) = w; }
        }
    }
};
struct EpiResF32 {
    static constexpr bool PERM = false, AFTER_DRAIN = false, USES_LDS = false;
    const float* base; const float* base2; int split_pm; float* out;
    __device__ __forceinline__ void operator()(const f32x4 (&acc)[2][2][4][2], const Unit& un, int wr, int wc, int fr, int fq) const {
        const int rloc = wr * 64 + fr, col0 = un.pn * BM + wc * 32 + 4 * fq;
        const float* bs = un.pm < split_pm ? base + (size_t)un.pm * BM * 4096 : base2 + (size_t)(un.pm - split_pm) * BM * 4096;
        float* os = out + (size_t)un.pm * BM * 4096;
#pragma unroll
        for (int ai = 0; ai < 2; ++ai)
#pragma unroll
            for (int m = 0; m < 4; ++m) { const size_t off = (size_t)(rloc + ai * HALF + m * 16) * 4096 + col0;
#pragma unroll
                for (int bj = 0; bj < 2; ++bj)
#pragma unroll
                    for (int n = 0; n < 2; ++n) { const f32x4 b = *(const f32x4*)(bs + off + bj * HALF + n * 16); *(f32x4*)(os + off + bj * HALF + n * 16) = b + acc[ai][bj][m][n]; } }
    }
};


struct EpiResNorm {
    static constexpr bool PERM = true, AFTER_DRAIN = false, USES_LDS = true, HALF_OK = true;
    const float* base; const float* base2; int split_pm; bf16_t* hb16; float* ssq;
    __device__ __forceinline__ void run(const f32x4 (&acc)[2][2][4][2], const Unit& un, int wr, int wc, int fr, int fq, PG8_LAS unsigned char* xl) const {
        asm volatile("" : "+v"(fr));
        const int rloc = wr * 64 + fr, col0 = un.pn * BM + wc * 32 + 8 * fq;
        const float* bs = un.pm < split_pm ? base + (size_t)un.pm * BM * 4096 : base2 + (size_t)(un.pm - split_pm) * BM * 4096;
        bf16_t* hs = hb16 + (size_t)un.pm * BM * 4096;
        PG8_LAS float* X = (PG8_LAS float*)xl;
#pragma unroll
        for (int ai = 0; ai < 2; ++ai) {
            f32x4 bb[4][2][2];
#pragma unroll
            for (int m = 0; m < 4; ++m)
#pragma unroll
                for (int bj = 0; bj < 2; ++bj)
#pragma unroll
                    for (int n = 0; n < 2; ++n) bb[m][bj][n] = *(const PG8_GAS f32x4*)(bs + (size_t)(rloc + ai * HALF + m * 16) * 4096 + col0 + bj * HALF + 4 * n);
            asm volatile("" ::: "memory");
#pragma unroll
            for (int m = 0; m < 4; ++m) { float s = 0.f;
#pragma unroll
                for (int bj = 0; bj < 2; ++bj) { const f32x4 h0 = bb[m][bj][0] + acc[ai][bj][m][0], h1 = bb[m][bj][1] + acc[ai][bj][m][1];
                    s += ((h0[0] * h0[0] + h0[1] * h0[1]) + (h0[2] * h0[2] + h0[3] * h0[3])) + ((h1[0] * h1[0] + h1[1] * h1[1]) + (h1[2] * h1[2] + h1[3] * h1[3]));
                    u32x4 w; w.x = cvt_pk_bf16(h0[0], h0[1]); w.y = cvt_pk_bf16(h0[2], h0[3]); w.z = cvt_pk_bf16(h1[0], h1[1]); w.w = cvt_pk_bf16(h1[2], h1[3]);
                    *(PG8_GAS u32x4*)(hs + (size_t)(rloc + ai * HALF + m * 16) * 4096 + col0 + bj * HALF) = w; }
                s += __shfl_xor(s, 16); s += __shfl_xor(s, 32);
                if (fq == 0) X[wc * 256 + rloc + ai * HALF + m * 16] = s; }
        }
        asm volatile("s_waitcnt lgkmcnt(0)" ::: "memory"); __builtin_amdgcn_s_barrier(); asm volatile("" ::: "memory");
        const int th = wc * 64 + fq * 16 + fr;
        if (th < 128) { const int t = wr * 64 + (th & 63) + (th >> 6) * 128; atomicAdd(ssq + (size_t)un.pm * BM + t, (X[t] + X[256 + t]) + (X[512 + t] + X[768 + t])); }
    }
};
struct EpiResBf16 {
    static constexpr bool PERM = true, AFTER_DRAIN = false, USES_LDS = false;
    bf16_t* h;
    __device__ __forceinline__ void operator()(const f32x4 (&acc)[2][2][4][2], const Unit& un, int wr, int wc, int fr, int fq) const {
        const int row0 = un.pm * BM + wr * 64 + fr, col0 = un.pn * BM + wc * 32 + 8 * fq;
        u32x4 rr[2][4][2];
#pragma unroll
        for (int ai = 0; ai < 2; ++ai)
#pragma unroll
            for (int m = 0; m < 4; ++m)
#pragma unroll
                for (int bj = 0; bj < 2; ++bj) rr[ai][m][bj] = *(const PG8_GAS u32x4*)((PG8_GAS bf16_t*)h + (size_t)(row0 + ai * HALF + m * 16) * 4096 + col0 + bj * HALF);
        asm volatile("" ::: "memory");
#pragma unroll
        for (int ai = 0; ai < 2; ++ai)
#pragma unroll
            for (int m = 0; m < 4; ++m)
#pragma unroll
                for (int bj = 0; bj < 2; ++bj) { const u32x4 r = rr[ai][m][bj]; const f32x4 v0 = acc[ai][bj][m][0], v1 = acc[ai][bj][m][1];
                    u32x4 w; w.x = cvt_pk_bf16(v0[0] + bf_lo(r.x), v0[1] + bf_hi(r.x)); w.y = cvt_pk_bf16(v0[2] + bf_lo(r.y), v0[3] + bf_hi(r.y));
                    w.z = cvt_pk_bf16(v1[0] + bf_lo(r.z), v1[1] + bf_hi(r.z)); w.w = cvt_pk_bf16(v1[2] + bf_lo(r.w), v1[3] + bf_hi(r.w));
                    *(PG8_GAS u32x4*)((PG8_GAS bf16_t*)h + (size_t)(row0 + ai * HALF + m * 16) * 4096 + col0 + bj * HALF) = w; }
    }
};
__device__ __forceinline__ float dpp_ror1(float x)  { return __int_as_float(__builtin_amdgcn_update_dpp(0, __float_as_int(x), 0x121, 0xf, 0xf, true)); }
__device__ __forceinline__ float dpp_ror15(float x) { return __int_as_float(__builtin_amdgcn_update_dpp(0, __float_as_int(x), 0x12f, 0xf, 0xf, true)); }
__device__ __forceinline__ float fma_s(float a, float b, float c) { float d; asm("v_fma_f32 %0, %1, %2, %3" : "=v"(d) : "v"(a), "v"(b), "v"(c)); return d; }
__device__ __forceinline__ float mul_s(float a, float b) { float d; asm("v_mul_f32 %0, %1, %2" : "=v"(d) : "v"(a), "v"(b)); return d; }
#define PG8_ROR1(x) dpp_ror1(x)
#define PG8_ROR15(x) dpp_ror15(x)
struct EpiConvGlu {
    static constexpr bool PERM = true, AFTER_DRAIN = false, USES_LDS = true, HALF_OK = false;
    bf16_t* act; float* hb; const float* cw; const float* cb; int dff, nup; const float* ssq; float inv_n, eps;
    __device__ __forceinline__ void run(f32x4 (&acc)[2][2][4][2], const Unit& un, int wr, int wc, int fr, int fq, PG8_LAS unsigned char* xl) const {
        asm volatile("" : "+v"(fr), "+v"(fq));
        const int cl = wc * 32 + 8 * fq;
#pragma unroll
        for (int ai = 0; ai < 2; ++ai)
#pragma unroll
            for (int m = 0; m < 4; ++m) { const float iv = __builtin_amdgcn_rsqf(ssq[(size_t)un.pm * BM + wr * 64 + fr + ai * HALF + m * 16] * inv_n + eps);
#pragma unroll
                for (int bj = 0; bj < 2; ++bj)
#pragma unroll
                    for (int n = 0; n < 2; ++n) acc[ai][bj][m][n] = acc[ai][bj][m][n] * iv; }
        PG8_LAS float* X = (PG8_LAS float*)xl;
#pragma unroll
        for (int ai = 0; ai < 2; ++ai) { const int blk = ai * 2 + wr;
            if (fr == 0) {
#pragma unroll
                for (int bj = 0; bj < 2; ++bj) { *(PG8_LAS f32x4*)(X + (blk * 2 + 0) * 256 + bj * 128 + cl) = acc[ai][bj][0][0]; *(PG8_LAS f32x4*)(X + (blk * 2 + 0) * 256 + bj * 128 + cl + 4) = acc[ai][bj][0][1]; } }
            if (fr == 15) {
#pragma unroll
                for (int bj = 0; bj < 2; ++bj) { *(PG8_LAS f32x4*)(X + (blk * 2 + 1) * 256 + bj * 128 + cl) = acc[ai][bj][3][0]; *(PG8_LAS f32x4*)(X + (blk * 2 + 1) * 256 + bj * 128 + cl + 4) = acc[ai][bj][3][1]; } } }
        asm volatile("s_waitcnt lgkmcnt(0)" ::: "memory"); __builtin_amdgcn_s_barrier(); asm volatile("" ::: "memory");
        { float* hrow = hb + ((size_t)un.pm * 4) * nup + (size_t)un.pn * 256 + cl;
          if (wr == 0 && fr < 2) {
#pragma unroll
              for (int bj = 0; bj < 2; ++bj) { *(f32x4*)(hrow + (size_t)fr * nup + bj * 128) = acc[0][bj][0][0]; *(f32x4*)(hrow + (size_t)fr * nup + bj * 128 + 4) = acc[0][bj][0][1]; } }
          if (wr == 1 && fr >= 14) {
#pragma unroll
              for (int bj = 0; bj < 2; ++bj) { *(f32x4*)(hrow + (size_t)(fr - 12) * nup + bj * 128) = acc[1][bj][3][0]; *(f32x4*)(hrow + (size_t)(fr - 12) * nup + bj * 128 + 4) = acc[1][bj][3][1]; } } }
        const bool e0 = fr == 0, e15 = fr == 15;
        const int row0 = un.pm * BM + wr * 64 + fr;
        typedef unsigned u32x2 __attribute__((ext_vector_type(2)));
#pragma unroll
        for (int ai = 0; ai < 2; ++ai) { const int blk = ai * 2 + wr;
            u32x2 keep[4];
#pragma unroll
            for (int n = 0; n < 2; ++n) {
                const int j = un.pn * 128 + cl + 4 * n;
                const f32x4 w0g = *(const PG8_GAS f32x4*)(cw + j), w1g = *(const PG8_GAS f32x4*)(cw + nup + j), w2g = *(const PG8_GAS f32x4*)(cw + 2 * (size_t)nup + j), bg = *(const PG8_GAS f32x4*)(cb + j);
                const f32x4 w0v = *(const PG8_GAS f32x4*)(cw + dff + j), w1v = *(const PG8_GAS f32x4*)(cw + nup + dff + j), w2v = *(const PG8_GAS f32x4*)(cw + 2 * (size_t)nup + dff + j), bv = *(const PG8_GAS f32x4*)(cb + dff + j);
                f32x4 hpg, hpv, hng, hnv;
                if (blk > 0) { hpg = *(const PG8_LAS f32x4*)(X + ((blk - 1) * 2 + 1) * 256 + cl + 4 * n); hpv = *(const PG8_LAS f32x4*)(X + ((blk - 1) * 2 + 1) * 256 + 128 + cl + 4 * n); } else { hpg = (f32x4){0.f, 0.f, 0.f, 0.f}; hpv = hpg; }
                if (blk < 3) { hng = *(const PG8_LAS f32x4*)(X + ((blk + 1) * 2 + 0) * 256 + cl + 4 * n); hnv = *(const PG8_LAS f32x4*)(X + ((blk + 1) * 2 + 0) * 256 + 128 + cl + 4 * n); } else { hng = (f32x4){0.f, 0.f, 0.f, 0.f}; hnv = hng; }
#pragma unroll
                for (int m = 0; m < 4; ++m) {
                    float o[4];
#pragma unroll
                    for (int e = 0; e < 4; ++e) {
                        const float g = acc[ai][0][m][n][e], v = acc[ai][1][m][n][e];
                        const float gpe = m > 0 ? PG8_ROR1(acc[ai][0][m - 1][n][e]) : hpg[e], vpe = m > 0 ? PG8_ROR1(acc[ai][1][m - 1][n][e]) : hpv[e];
                        const float gne = m < 3 ? PG8_ROR15(acc[ai][0][m + 1][n][e]) : hng[e], vne = m < 3 ? PG8_ROR15(acc[ai][1][m + 1][n][e]) : hnv[e];
                        const float gpi = PG8_ROR1(g), vpi = PG8_ROR1(v), gni = PG8_ROR15(g), vni = PG8_ROR15(v);
                        const float gp = e0 ? gpe : gpi, vp = e0 ? vpe : vpi, gn = e15 ? gne : gni, vn = e15 ? vne : vni;
                        const float cg = fma_s(w2g[e], gn, fma_s(w1g[e], g, fma_s(w0g[e], gp, bg[e]))), cv = fma_s(w2v[e], vn, fma_s(w1v[e], v, fma_s(w0v[e], vp, bv[e])));
                        o[e] = (cg * cv) * __builtin_amdgcn_rcpf(1.0f + __builtin_amdgcn_exp2f(cg * -1.4426950408889634f));
                    }
                    if (n == 0) { keep[m].x = cvt_pk_bf16(o[0], o[1]); keep[m].y = cvt_pk_bf16(o[2], o[3]); }
                    else { u32x4 w; w.x = keep[m].x; w.y = keep[m].y; w.z = cvt_pk_bf16(o[0], o[1]); w.w = cvt_pk_bf16(o[2], o[3]);
                        *(PG8_GAS u32x4*)(act + (size_t)(row0 + ai * HALF + m * 16) * dff + j - 4) = w; }
                }
                __builtin_amdgcn_sched_barrier(0);
            }
        }
    }
};

typedef int i32x4v __attribute__((ext_vector_type(4)));
typedef int i32x8v __attribute__((ext_vector_type(8)));
__device__ __forceinline__ i32x8v cat8(bf16x8 a, bf16x8 b) { return __builtin_shufflevector(__builtin_bit_cast(i32x4v, a), __builtin_bit_cast(i32x4v, b), 0, 1, 2, 3, 4, 5, 6, 7); }
template <class Epi, class Sched, bool ALIGN_EPI = false, bool SP2 = false, bool F8 = false>
__device__ __forceinline__ void gemm_phase(PG8_LAS unsigned char* lds, const Gemm g, const Sched& S, const Epi& E) {
    int tid_ = threadIdx.x; asm volatile("" : "+v"(tid_));
    const int tid = tid_, wid = __builtin_amdgcn_readfirstlane(tid >> 6), lane = tid & 63, wr = wid >> 2, wc = wid & 3, fr = lane & 15, fq = lane >> 4;
    const int K = g.K, nt = K / BK;
    unsigned voffA[2], voffB[2];
#pragma unroll
    for (int i = 0; i < 2; ++i) { int R, C; stage_rc(tid * 16 + i * 8192, R, C); const int Rb = Epi::PERM ? ((R & ~31) + perm32(R & 31)) : R;
        voffA[i] = (unsigned)(R * g.lda + C) * 2u; voffB[i] = (unsigned)(Rb * g.ldb + C) * 2u; }
    const size_t kstep = (size_t)(BK * 2);
    const size_t hA = (size_t)HALF * g.lda * 2, hB = (size_t)HALF * g.ldb * 2;
    const size_t tA = 2 * hA, tB = 2 * hB;
    const unsigned ldsw = (unsigned)wid * 1024u;
    const int aoff = lds_byte(wr * 64 + fr, fq * 8), boff = lds_byte(wc * 32 + fr, fq * 8);
#define PG8_SA(b, h) (((b) * 2 + (h)) * HTB)
#define PG8_SB(b, h) ((4 + (b) * 2 + (h)) * HTB)
#define PG8_STAGE(bufoff, gbase, voff) do { _Pragma("unroll") for (int _i = 0; _i < 2; ++_i) \
        __builtin_amdgcn_global_load_lds((const unsigned*)((const char*)(gbase) + (voff)[_i]), (PG8_LAS unsigned*)(lds + (bufoff) + ldsw + _i * 8192), 16, 0, 0); } while (0)
#define PG8_LDA(dst, b, h) do { _Pragma("unroll") for (int m = 0; m < 4; ++m) _Pragma("unroll") for (int k = 0; k < 2; ++k) dst[m][k] = *(const PG8_LAS bf16x8*)(lds + PG8_SA(b, h) + aoff + m * 2048 + k * 1024); } while (0)
#define PG8_LDB(dst, b, h) do { _Pragma("unroll") for (int n = 0; n < 2; ++n) _Pragma("unroll") for (int k = 0; k < 2; ++k) dst[n][k] = *(const PG8_LAS bf16x8*)(lds + PG8_SB(b, h) + boff + n * 2048 + k * 1024); } while (0)
#define PG8_MMA(ai, bj, At, Bt) do { __builtin_amdgcn_s_setprio(1); \
    if constexpr (F8) { _Pragma("unroll") for (int m = 0; m < 4; ++m) _Pragma("unroll") for (int n = 0; n < 2; ++n) { const i32x8v a8_ = cat8(At[m][0], At[m][1]), b8_ = cat8(Bt[n][0], Bt[n][1]); \
        asm volatile("v_mfma_scale_f32_16x16x128_f8f6f4 %0, %1, %2, %0, %3, %3 op_sel_hi:[0,0,0]" : "+v"(acc[ai][bj][m][n]) : "v"(b8_), "v"(a8_), "v"(one8)); } } \
    else { _Pragma("unroll") for (int m = 0; m < 4; ++m) _Pragma("unroll") for (int n = 0; n < 2; ++n) _Pragma("unroll") for (int k = 0; k < 2; ++k) \
        acc[ai][bj][m][n] = __builtin_amdgcn_mfma_f32_16x16x32_bf16(Bt[n][k], At[m][k], acc[ai][bj][m][n], 0, 0, 0); } \
    __builtin_amdgcn_s_setprio(0); } while (0)
#define PG8_WAIT_V(n) asm volatile("s_waitcnt vmcnt(" #n ")" ::: "memory")
#define PG8_WAIT_L(n) asm volatile("s_waitcnt lgkmcnt(" #n ")" ::: "memory")
#define PG8_BAR __builtin_amdgcn_s_barrier()
#define PG8_SCHED __builtin_amdgcn_sched_barrier(0)
    int one8 = 0x7f7f7f7f; if constexpr (F8) one8 = Epi::F8_SB * 0x01010101; asm volatile("" : "+v"(one8));
    Unit cur, nxt; int ui = 0;
    if (!S.next(0, cur)) return;
    f32x4 acc[2][2][4][2];
#pragma unroll
    for (int a = 0; a < 2; ++a)
#pragma unroll
        for (int b = 0; b < 2; ++b)
#pragma unroll
            for (int m = 0; m < 4; ++m)
#pragma unroll
                for (int n = 0; n < 2; ++n) acc[a][b][m][n] = (f32x4){0.f, 0.f, 0.f, 0.f};
    bf16x8 At[4][2], B0[2][2], B1[2][2];
    const char* cA = (const char*)g.A + (size_t)cur.pm * tA + (size_t)(cur.pn >> g.gshift) * g.goff; const char* cB = (const char*)g.Bt + (size_t)cur.pn * tB;
    S.a_ready(cur);
    if constexpr (SP2) {
        PG8_STAGE(PG8_SB(0, 0), cB, voffB); PG8_STAGE(PG8_SB(0, 1), cB + hB, voffB); PG8_STAGE(PG8_SA(0, 0), cA, voffA); PG8_STAGE(PG8_SA(0, 1), cA + hA, voffA);
        if (wr == 1) PG8_BAR;
        PG8_WAIT_V(2); PG8_BAR;
        PG8_STAGE(PG8_SB(1, 0), cB + kstep, voffB); PG8_STAGE(PG8_SA(1, 0), cA + kstep, voffA); PG8_STAGE(PG8_SB(1, 1), cB + hB + kstep, voffB);
        PG8_WAIT_V(6); PG8_BAR;
    } else {
        PG8_STAGE(PG8_SB(0, 0), cB, voffB); PG8_STAGE(PG8_SA(0, 0), cA, voffA); PG8_STAGE(PG8_SB(0, 1), cB + hB, voffB); PG8_STAGE(PG8_SA(0, 1), cA + hA, voffA);
        if (wr == 1) PG8_BAR;
        PG8_WAIT_V(4); PG8_BAR;
        PG8_STAGE(PG8_SB(1, 0), cB + kstep, voffB); PG8_STAGE(PG8_SA(1, 0), cA + kstep, voffA); PG8_STAGE(PG8_SB(1, 1), cB + hB + kstep, voffB);
        PG8_WAIT_V(6); PG8_BAR;
    }
    for (;;) {
        const bool has_next = S.next(ui + 1, nxt);
        const char* nA = has_next ? (const char*)g.A + (size_t)nxt.pm * tA + (size_t)(nxt.pn >> g.gshift) * g.goff : cA; const char* nB = has_next ? (const char*)g.Bt + (size_t)nxt.pn * tB : cB;
        for (int t = 0; t < nt; t += 2) {
            const bool last = (t == nt - 2);
            const char* a1 = cA + (size_t)(t + 1) * kstep;
            const char* a2 = last ? nA : cA + (size_t)(t + 2) * kstep; const char* b2 = last ? nB : cB + (size_t)(t + 2) * kstep;
            const char* a3 = a2 + kstep; const char* b3 = b2 + kstep;
            if (last && has_next) S.a_ready(nxt);
            if constexpr (SP2) {
            PG8_LDB(B0, 0, 0); PG8_LDB(B1, 0, 1); PG8_SCHED; PG8_LDA(At, 0, 0); PG8_STAGE(PG8_SA(1, 1), a1 + hA, voffA);
            PG8_WAIT_V(8); PG8_WAIT_L(0); PG8_BAR; PG8_MMA(0, 0, At, B0); PG8_MMA(0, 1, At, B1); PG8_BAR; PG8_SCHED;
            PG8_LDA(At, 0, 1); PG8_STAGE(PG8_SB(0, 0), b2, voffB); PG8_STAGE(PG8_SB(0, 1), b2 + hB, voffB); PG8_STAGE(PG8_SA(0, 0), a2, voffA);
            PG8_WAIT_V(8); PG8_WAIT_L(0); PG8_BAR; PG8_MMA(1, 0, At, B0); PG8_MMA(1, 1, At, B1); PG8_BAR; PG8_SCHED;
            PG8_LDB(B0, 1, 0); PG8_LDB(B1, 1, 1); PG8_SCHED; PG8_LDA(At, 1, 0); PG8_STAGE(PG8_SA(0, 1), a2 + hA, voffA);
            PG8_WAIT_V(8); PG8_WAIT_L(0); PG8_BAR; PG8_MMA(0, 0, At, B0); PG8_MMA(0, 1, At, B1); PG8_BAR; PG8_SCHED;
            PG8_LDA(At, 1, 1); PG8_STAGE(PG8_SB(1, 0), b3, voffB); PG8_STAGE(PG8_SB(1, 1), b3 + hB, voffB); PG8_STAGE(PG8_SA(1, 0), a3, voffA);
            PG8_WAIT_V(8); PG8_WAIT_L(0); PG8_BAR; PG8_MMA(1, 0, At, B0); PG8_MMA(1, 1, At, B1); PG8_BAR; PG8_SCHED;
            } else {
            PG8_LDB(B0, 0, 0); PG8_SCHED; PG8_LDA(At, 0, 0); PG8_STAGE(PG8_SA(1, 1), a1 + hA, voffA);
            PG8_WAIT_L(8); PG8_BAR; PG8_WAIT_L(0); PG8_MMA(0, 0, At, B0); PG8_BAR; PG8_SCHED;
            PG8_LDB(B1, 0, 1); PG8_STAGE(PG8_SB(0, 0), b2, voffB);
            PG8_BAR; PG8_WAIT_L(0); PG8_MMA(0, 1, At, B1); PG8_BAR;
            PG8_LDA(At, 0, 1); PG8_STAGE(PG8_SA(0, 0), a2, voffA);
            PG8_BAR; PG8_WAIT_L(0); PG8_MMA(1, 0, At, B0); PG8_BAR; PG8_SCHED;
            PG8_STAGE(PG8_SB(0, 1), b2 + hB, voffB);
            PG8_WAIT_V(6); PG8_BAR; PG8_MMA(1, 1, At, B1); PG8_BAR;
            PG8_LDB(B0, 1, 0); PG8_SCHED; PG8_LDA(At, 1, 0); PG8_STAGE(PG8_SA(0, 1), a2 + hA, voffA);
            PG8_WAIT_L(8); PG8_BAR; PG8_WAIT_L(0); PG8_MMA(0, 0, At, B0); PG8_BAR; PG8_SCHED;
            PG8_LDB(B1, 1, 1); PG8_STAGE(PG8_SB(1, 0), b3, voffB);
            PG8_BAR; PG8_WAIT_L(0); PG8_MMA(0, 1, At, B1); PG8_BAR;
            PG8_LDA(At, 1, 1); PG8_STAGE(PG8_SA(1, 0), a3, voffA);
            PG8_BAR; PG8_WAIT_L(0); PG8_MMA(1, 0, At, B0); PG8_BAR; PG8_SCHED;
            PG8_STAGE(PG8_SB(1, 1), b3 + hB, voffB);
            PG8_WAIT_V(6); PG8_BAR; PG8_MMA(1, 1, At, B1); PG8_BAR;
            }
        }
        if constexpr (ALIGN_EPI) { if (wr == 0) PG8_BAR; }
        if constexpr (F8) asm volatile("s_nop 15\n\ts_nop 15\n\ts_nop 7" ::: "memory");
        if constexpr (!Epi::AFTER_DRAIN) { if constexpr (Epi::USES_LDS) { static_assert(ALIGN_EPI || Epi::HALF_OK, "an epilogue whose exchange crosses the two halves needs them aligned"); E.run(acc, cur, wr, wc, fr, fq, lds + XL_OFF); } else E(acc, cur, wr, wc, fr, fq); S.done(cur); }
        if (!has_next) break;
#pragma unroll
        for (int a = 0; a < 2; ++a)
#pragma unroll
            for (int b = 0; b < 2; ++b)
#pragma unroll
                for (int m = 0; m < 4; ++m)
#pragma unroll
                    for (int n = 0; n < 2; ++n) acc[a][b][m][n] = (f32x4){0.f, 0.f, 0.f, 0.f};
        cur = nxt; cA = nA; cB = nB; ++ui;
        if constexpr (ALIGN_EPI) { if (wr == 1) PG8_BAR; }
    }
    PG8_WAIT_V(0);
    if constexpr (!ALIGN_EPI) { if (wr == 0) PG8_BAR; }
    PG8_BAR;
    if constexpr (Epi::AFTER_DRAIN) { E.fused(acc, cur, wr, wc, fr, fq, lds, wid, lane); S.done(cur); }
#undef PG8_SA
#undef PG8_SB
#undef PG8_STAGE
#undef PG8_LDA
#undef PG8_LDB
#undef PG8_MMA
#undef PG8_WAIT_V
#undef PG8_WAIT_L
#undef PG8_BAR
#undef PG8_SCHED
}
}

namespace att {
#define ATT_LAS __attribute__((address_space(3)))
typedef unsigned short bf16_t;
using bf16x8 = __attribute__((ext_vector_type(8))) short;
using s16x4  = __attribute__((ext_vector_type(4))) short;
using f32x16 = __attribute__((ext_vector_type(16))) float;
using u32x4  = __attribute__((ext_vector_type(4))) unsigned;
constexpr int   D = 128, NW = 8, QBLK = 32, KVBLK = 64;
constexpr float SCALE = 0.088388347648318440f;
constexpr float THR = 8.f;
#ifndef ATT_SDEPTH
#define ATT_SDEPTH 1
#endif
constexpr int SDEPTH = ATT_SDEPTH;
constexpr int LDQ = 2048, LDK = 512, LDO = 2048;
constexpr int SHM_V = KVBLK * D * 2, SHM_K = KVBLK * D * 2, SHM_ATTN = 2 * SHM_V + 2 * SHM_K + NW * 64 * 4;
#define KSWZ(row, colB) ((row) * 256 + ((colB) ^ (((row) & 7) << 4)))
#define SBAR() __builtin_amdgcn_sched_barrier(0)
__device__ __forceinline__ int crow(int r, int hi) { return (r & 3) + 8 * (r >> 2) + 4 * hi; }
__device__ __forceinline__ unsigned cvtpk(float lo, float hi) { return pg8::cvt_pk_bf16(lo, hi); }

__device__ __forceinline__ void partialSM(f32x16& p0, f32x16& p1, float& m_reg, float& mn, float& alpha) {
  constexpr float C = SCALE * 1.4426950408889634f;
  float pmax = p0[0];
#pragma unroll
  for (int r = 1; r < 16; ++r) pmax = fmaxf(pmax, p0[r]);
#pragma unroll
  for (int r = 0; r < 16; ++r) pmax = fmaxf(pmax, p1[r]);
  { auto rr = __builtin_amdgcn_permlane32_swap(__float_as_uint(pmax), __float_as_uint(pmax), false, false);
    pmax = fmaxf(__uint_as_float(rr[0]), __uint_as_float(rr[1])); }
  if (__builtin_expect(__all(pmax - m_reg <= THR / SCALE), 1)) { mn = m_reg; alpha = 1.f; }
  else { mn = fmaxf(m_reg, pmax); alpha = __builtin_amdgcn_exp2f((m_reg - mn) * C); m_reg = mn; }
  float mnC = -mn * C;
#pragma unroll
  for (int r = 0; r < 16; ++r) p0[r] = fmaf(p0[r], C, mnC);
#pragma unroll
  for (int r = 0; r < 16; ++r) p1[r] = fmaf(p1[r], C, mnC);
#pragma unroll
  for (int r = 0; r < 16; ++r) p0[r] = __builtin_amdgcn_exp2f(p0[r]);
}
__device__ __forceinline__ void finishSM(f32x16& p0, f32x16& p1, float alpha, float& l_reg, bf16x8& pa0, bf16x8& pa1, bf16x8& pa2, bf16x8& pa3) {
#pragma unroll
  for (int r = 0; r < 16; ++r) p1[r] = __builtin_amdgcn_exp2f(p1[r]);
  float ps = 0;
#pragma unroll
  for (int r = 0; r < 16; ++r) ps += p0[r];
#pragma unroll
  for (int r = 0; r < 16; ++r) ps += p1[r];
  { auto rr = __builtin_amdgcn_permlane32_swap(__float_as_uint(ps), __float_as_uint(ps), false, false);
    ps = __uint_as_float(rr[0]) + __uint_as_float(rr[1]); }
  l_reg = l_reg * alpha + ps;
#define PK4(P, BASE, OUT) do { unsigned a0 = cvtpk(P[BASE + 0], P[BASE + 1]), a1 = cvtpk(P[BASE + 2], P[BASE + 3]);   \
    unsigned b0 = cvtpk(P[BASE + 4], P[BASE + 5]), b1 = cvtpk(P[BASE + 6], P[BASE + 7]);                              \
    auto r0 = __builtin_amdgcn_permlane32_swap(a0, b0, false, false); auto r1 = __builtin_amdgcn_permlane32_swap(a1, b1, false, false); \
    u32x4 w = {r0[0], r1[0], r0[1], r1[1]}; OUT = *reinterpret_cast<bf16x8*>(&w); } while (0)
  PK4(p0, 0, pa0); PK4(p0, 8, pa1); PK4(p1, 0, pa2); PK4(p1, 8, pa3);
#undef PK4
}
__device__ __forceinline__ void qkt(f32x16& p0, f32x16& p1, const ATT_LAS char* Ks, const bf16x8* qr, int r32, int hi) {
  p0 = f32x16{}; p1 = f32x16{};
#pragma unroll
  for (int d0 = 0; d0 < 8; ++d0) { const int cb = (d0 * 16 + hi * 8) * 2;
    const bf16x8 b0 = *reinterpret_cast<const ATT_LAS bf16x8*>(Ks + KSWZ(r32, cb));
    const bf16x8 b1 = *reinterpret_cast<const ATT_LAS bf16x8*>(Ks + KSWZ(32 + r32, cb));
    p0 = __builtin_amdgcn_mfma_f32_32x32x16_bf16(b0, qr[d0], p0, 0, 0, 0);
    p1 = __builtin_amdgcn_mfma_f32_32x32x16_bf16(b1, qr[d0], p1, 0, 0, 0); }
}
__device__ __forceinline__ int v_st(int k, int c) { const int kk = (k & ~0xC) | ((k & 4) << 1) | ((k & 8) >> 1); return ((kk >> 3) * 4 + (c >> 5)) * 512 + ((kk & 7) * 32 + (c & 31)) * 2; }
__device__ __forceinline__ int v_rd_base(int lane) { return ((lane & 3) << 3) | (((lane >> 2) & 3) << 6) | (((lane >> 4) & 1) << 5) | (((lane >> 5) & 1) << 8); }
constexpr int v_rd_off(int d0, int ks, int half) { return d0 * 512 + ks * 4096 + half * 2048; }
template <int OFF> __device__ __forceinline__ s16x4 tr_read(int vb) {
  s16x4 r; asm volatile("ds_read_b64_tr_b16 %0, %1 offset:%2" : "=&v"(r) : "v"(vb), "i"(OFF) : "memory"); return r;
}
template <int D0> __device__ __forceinline__ void pv_one(f32x16& od, int vb, bf16x8 pa0, bf16x8 pa1, bf16x8 pa2, bf16x8 pa3) {
  const s16x4 l0 = tr_read<v_rd_off(D0, 0, 0)>(vb), h0 = tr_read<v_rd_off(D0, 0, 1)>(vb), l1 = tr_read<v_rd_off(D0, 1, 0)>(vb), h1 = tr_read<v_rd_off(D0, 1, 1)>(vb);
  const s16x4 l2 = tr_read<v_rd_off(D0, 2, 0)>(vb), h2 = tr_read<v_rd_off(D0, 2, 1)>(vb), l3 = tr_read<v_rd_off(D0, 3, 0)>(vb), h3 = tr_read<v_rd_off(D0, 3, 1)>(vb);
  asm volatile("s_waitcnt lgkmcnt(0)" ::: "memory"); SBAR();
#define PK(L, H) (bf16x8){L[0], L[1], L[2], L[3], H[0], H[1], H[2], H[3]}
  od = __builtin_amdgcn_mfma_f32_32x32x16_bf16(pa0, PK(l0, h0), od, 0, 0, 0);
  od = __builtin_amdgcn_mfma_f32_32x32x16_bf16(pa1, PK(l1, h1), od, 0, 0, 0);
  od = __builtin_amdgcn_mfma_f32_32x32x16_bf16(pa2, PK(l2, h2), od, 0, 0, 0);
  od = __builtin_amdgcn_mfma_f32_32x32x16_bf16(pa3, PK(l3, h3), od, 0, 0, 0);
#undef PK
}
__device__ __forceinline__ void pv_d0(f32x16* o, int vb, bf16x8 pa0, bf16x8 pa1, bf16x8 pa2, bf16x8 pa3) {
  pv_one<0>(o[0], vb, pa0, pa1, pa2, pa3); pv_one<1>(o[1], vb, pa0, pa1, pa2, pa3); pv_one<2>(o[2], vb, pa0, pa1, pa2, pa3); pv_one<3>(o[3], vb, pa0, pa1, pa2, pa3);
}
constexpr float O8SCALE = 16.0f;
__device__ __forceinline__ void attn_unit(const bf16_t* __restrict__ Qb, const bf16_t* __restrict__ Kh, const bf16_t* __restrict__ Vh, unsigned char* __restrict__ Ob, int seq, ATT_LAS char* lds,
                                          const float* __restrict__ qg, const float* __restrict__ tab, int tpos0) {
  int tid_ = threadIdx.x; asm volatile("" : "+v"(tid_));
  const int tid = tid_, wid = tid >> 6, lane = tid & 63, r32 = lane & 31, hi = lane >> 5;
  ATT_LAS char* V_lds = lds; ATT_LAS char* K_lds = lds + 2 * SHM_V;
  ATT_LAS float* ws = (ATT_LAS float*)(lds + 2 * SHM_V + 2 * SHM_K) + wid * 64; ATT_LAS float* li_l = ws; ATT_LAS float* al_l = ws + 32;
  float m_reg = -1e30f, l_reg = 0; f32x16 o[4] = {}; bf16x8 qr[8];
  const bf16_t* Qw = Qb + (long)(wid * QBLK + r32) * LDQ + hi * 8;
#pragma unroll
  for (int d0 = 0; d0 < 8; ++d0) qr[d0] = *reinterpret_cast<const bf16x8*>(Qw + d0 * 16);
  {
    typedef float f32x4a __attribute__((ext_vector_type(4)));
    float x[8][8]; float ss = 0.f;
#pragma unroll
    for (int d0 = 0; d0 < 8; ++d0)
#pragma unroll
      for (int e = 0; e < 8; ++e) { x[d0][e] = __uint_as_float((unsigned)(unsigned short)qr[d0][e] << 16); ss += x[d0][e] * x[d0][e]; }
    { auto rr = __builtin_amdgcn_permlane32_swap(__float_as_uint(ss), __float_as_uint(ss), false, false); ss = __uint_as_float(rr[0]) + __uint_as_float(rr[1]); }
    const float inv = 1.0f / sqrtf(ss * (1.0f / 128.0f) + 1e-6f);
#pragma unroll
    for (int d0 = 0; d0 < 8; ++d0) { const f32x4a g0 = *reinterpret_cast<const f32x4a*>(qg + d0 * 16 + hi * 8), g1 = *reinterpret_cast<const f32x4a*>(qg + d0 * 16 + hi * 8 + 4);
#pragma unroll
      for (int e = 0; e < 4; ++e) { x[d0][e] = x[d0][e] * inv * g0[e]; x[d0][4 + e] = x[d0][4 + e] * inv * g1[e]; } }
    const int tq = tpos0 + wid * QBLK + r32;
#pragma unroll
    for (int ax = 0; ax < 2; ++ax) { const int pos = ax == 0 ? (tq >> 6) : (tq & 63);
#pragma unroll
      for (int h = 0; h < 2; ++h) { const f32x4a* tp = reinterpret_cast<const f32x4a*>(tab + (size_t)(pos * 32 + h * 16 + hi * 8) * 2);
#pragma unroll
        for (int e2 = 0; e2 < 4; ++e2) { const f32x4a cs = tp[e2];
#pragma unroll
          for (int k = 0; k < 2; ++k) { const int e = 2 * e2 + k; const float c = cs[2 * k], s = cs[2 * k + 1]; const float u0 = x[ax * 4 + h][e], u1 = x[ax * 4 + 2 + h][e];
            x[ax * 4 + h][e] = u0 * c - u1 * s; x[ax * 4 + 2 + h][e] = u1 * c + u0 * s; } } } }
#pragma unroll
    for (int d0 = 0; d0 < 8; ++d0) { u32x4 w = {cvtpk(x[d0][0], x[d0][1]), cvtpk(x[d0][2], x[d0][3]), cvtpk(x[d0][4], x[d0][5]), cvtpk(x[d0][6], x[d0][7])}; qr[d0] = *reinterpret_cast<bf16x8*>(&w); }
  }
  const int sr = tid >> 4, sc = (tid & 15) * 8, vst0 = v_st(sr, sc), vst1 = v_st(32 + sr, sc);
  const int vb0 = (int)(uintptr_t)V_lds + v_rd_base(lane);
  bf16x8 sv0[SDEPTH], sv1[SDEPTH], sk0[SDEPTH], sk1[SDEPTH];
#define SLOAD(i, k0) do { sv0[i] = *reinterpret_cast<const bf16x8*>(&Vh[(long)((k0) + sr) * LDK + sc]); sv1[i] = *reinterpret_cast<const bf16x8*>(&Vh[(long)((k0) + 32 + sr) * LDK + sc]); \
    sk0[i] = *reinterpret_cast<const bf16x8*>(&Kh[(long)((k0) + sr) * LDK + sc]); sk1[i] = *reinterpret_cast<const bf16x8*>(&Kh[(long)((k0) + 32 + sr) * LDK + sc]); } while (0)
#define SWRITE(b, i) do { *(ATT_LAS bf16x8*)(V_lds + (b) * SHM_V + vst0) = sv0[i]; *(ATT_LAS bf16x8*)(V_lds + (b) * SHM_V + vst1) = sv1[i]; const int kc = sc * 2; \
    *(ATT_LAS bf16x8*)(K_lds + (b) * SHM_K + KSWZ(sr, kc)) = sk0[i]; *(ATT_LAS bf16x8*)(K_lds + (b) * SHM_K + KSWZ(32 + sr, kc)) = sk1[i]; } while (0)
#define SWAIT() do { if constexpr (SDEPTH == 2) asm volatile("s_waitcnt vmcnt(4)" ::: "memory"); else asm volatile("s_waitcnt vmcnt(0)" ::: "memory"); } while (0)
#define RESC(a) do { if (__any((a) < 1.f)) { if (hi == 0) al_l[r32] = (a); asm volatile("s_waitcnt lgkmcnt(0)" ::: "memory"); \
    _Pragma("unroll") for (int d = 0; d < 4; ++d) _Pragma("unroll") for (int r = 0; r < 16; ++r) o[d][r] *= al_l[crow(r, hi)]; } } while (0)
  f32x16 pA0, pA1, pB0, pB1; float mnA, mnB, alA, alB; bf16x8 pa0, pa1, pa2, pa3; const int NT = seq / KVBLK;
  constexpr int SE = 0, SO = SDEPTH - 1;
  SLOAD(SE, 0); asm volatile("s_waitcnt vmcnt(0)" ::: "memory"); SWRITE(0, SE); __syncthreads();
  qkt(pA0, pA1, K_lds, qr, r32, hi); partialSM(pA0, pA1, m_reg, mnA, alA);
  SLOAD(SO, KVBLK); if constexpr (SDEPTH == 2) { if (2 < NT) SLOAD(SE, 2 * KVBLK); }
  SWAIT(); SWRITE(1, SO); __syncthreads();
  for (int j = 1; j + 1 < NT; j += 2) {
    SBAR(); qkt(pB0, pB1, K_lds + SHM_K, qr, r32, hi);
    finishSM(pA0, pA1, alA, l_reg, pa0, pa1, pa2, pa3); SBAR();
    SLOAD(SO, (j + SDEPTH) * KVBLK); SBAR();
    pv_d0(o, vb0, pa0, pa1, pa2, pa3); partialSM(pB0, pB1, m_reg, mnB, alB);
    __syncthreads(); SWAIT(); SWRITE(0, SE);
    RESC(alB); __syncthreads();
    SBAR(); qkt(pA0, pA1, K_lds, qr, r32, hi);
    finishSM(pB0, pB1, alB, l_reg, pa0, pa1, pa2, pa3); SBAR();
    if (SDEPTH == 1 || j + 3 < NT) SLOAD(SE, (j + 1 + SDEPTH) * KVBLK); SBAR();
    pv_d0(o, vb0 + SHM_V, pa0, pa1, pa2, pa3); partialSM(pA0, pA1, m_reg, mnA, alA);
    __syncthreads(); SWAIT(); SWRITE(1, SO);
    RESC(alA); __syncthreads();
  }
  SBAR(); qkt(pB0, pB1, K_lds + SHM_K, qr, r32, hi);
  finishSM(pA0, pA1, alA, l_reg, pa0, pa1, pa2, pa3); SBAR();
  pv_d0(o, vb0, pa0, pa1, pa2, pa3); partialSM(pB0, pB1, m_reg, mnB, alB);
  __syncthreads(); RESC(alB);
  finishSM(pB0, pB1, alB, l_reg, pa0, pa1, pa2, pa3); SBAR();
  pv_d0(o, vb0 + SHM_V, pa0, pa1, pa2, pa3);
  if (hi == 0) li_l[r32] = l_reg; asm volatile("s_waitcnt lgkmcnt(0)" ::: "memory");
  float rli[16];
#pragma unroll
  for (int r = 0; r < 16; ++r) rli[r] = __builtin_amdgcn_rcpf(li_l[crow(r, hi)]);
  unsigned char* Ow = Ob + (long)(wid * QBLK) * LDO;
#pragma unroll
  for (int r = 0; r < 16; ++r) { const int orow = crow(r, hi);
#pragma unroll
    for (int d0 = 0; d0 < 4; ++d0) { const float x = o[d0][r] * rli[r] * O8SCALE; Ow[(long)orow * LDO + d0 * 32 + r32] = (unsigned char)(__builtin_amdgcn_cvt_pk_fp8_f32(x, x, 0, false) & 0xff); } }
  __syncthreads();
#undef SLOAD
#undef SWRITE
#undef SWAIT
#undef RESC
}
constexpr float THR8 = 5.f;
constexpr int VT_STRIDE = 4 * 8192;
typedef int i32x8a __attribute__((ext_vector_type(8)));
typedef int i32x4a __attribute__((ext_vector_type(4)));
__device__ __forceinline__ unsigned pk4f8(float a, float b, float c, float d) { unsigned w = 0u; w = __builtin_amdgcn_cvt_pk_fp8_f32(a, b, w, false); w = __builtin_amdgcn_cvt_pk_fp8_f32(c, d, w, true); return w; }
__device__ __forceinline__ i32x8a ld32(const ATT_LAS char* p0, const ATT_LAS char* p1) { const i32x4a a = *reinterpret_cast<const ATT_LAS i32x4a*>(p0), b = *reinterpret_cast<const ATT_LAS i32x4a*>(p1); return __builtin_shufflevector(a, b, 0, 1, 2, 3, 4, 5, 6, 7); }
#define MFMA8(acc, a8, b8, one) asm volatile("v_mfma_scale_f32_32x32x64_f8f6f4 %0, %1, %2, %0, %3, %3 op_sel_hi:[0,0,0]" : "+v"(acc) : "v"(a8), "v"(b8), "v"(one))
__device__ __forceinline__ void partialSM8(f32x16& p0, f32x16& p1, float& m_reg, float& mn, float& alpha) {
  constexpr float C = SCALE * 1.4426950408889634f;
  float pmax = p0[0];
#pragma unroll
  for (int r = 1; r < 16; ++r) pmax = fmaxf(pmax, p0[r]);
#pragma unroll
  for (int r = 0; r < 16; ++r) pmax = fmaxf(pmax, p1[r]);
  { auto rr = __builtin_amdgcn_permlane32_swap(__float_as_uint(pmax), __float_as_uint(pmax), false, false);
    pmax = fmaxf(__uint_as_float(rr[0]), __uint_as_float(rr[1])); }
  if (__builtin_expect(__all(pmax - m_reg <= THR8 / SCALE), 1)) { mn = m_reg; alpha = 1.f; }
  else { mn = fmaxf(m_reg, pmax); alpha = __builtin_amdgcn_exp2f((m_reg - mn) * C); m_reg = mn; }
  float mnC = -mn * C;
#pragma unroll
  for (int r = 0; r < 16; ++r) p0[r] = fmaf(p0[r], C, mnC);
#pragma unroll
  for (int r = 0; r < 16; ++r) p1[r] = fmaf(p1[r], C, mnC);
#pragma unroll
  for (int r = 0; r < 16; ++r) p0[r] = __builtin_amdgcn_exp2f(p0[r]);
}
__device__ __forceinline__ void finishSM8(f32x16& p0, f32x16& p1, float alpha, float& l_reg, i32x8a& pa) {
#pragma unroll
  for (int r = 0; r < 16; ++r) p1[r] = __builtin_amdgcn_exp2f(p1[r]);
  float ps = 0;
#pragma unroll
  for (int r = 0; r < 16; ++r) ps += p0[r];
#pragma unroll
  for (int r = 0; r < 16; ++r) ps += p1[r];
  { auto rr = __builtin_amdgcn_permlane32_swap(__float_as_uint(ps), __float_as_uint(ps), false, false);
    ps = __uint_as_float(rr[0]) + __uint_as_float(rr[1]); }
  l_reg = l_reg * alpha + ps;
  pa = (i32x8a){(int)pk4f8(p0[0], p0[1], p0[2], p0[3]), (int)pk4f8(p0[4], p0[5], p0[6], p0[7]), (int)pk4f8(p0[8], p0[9], p0[10], p0[11]), (int)pk4f8(p0[12], p0[13], p0[14], p0[15]),
                (int)pk4f8(p1[0], p1[1], p1[2], p1[3]), (int)pk4f8(p1[4], p1[5], p1[6], p1[7]), (int)pk4f8(p1[8], p1[9], p1[10], p1[11]), (int)pk4f8(p1[12], p1[13], p1[14], p1[15])};
}
__device__ __forceinline__ int k8_off(int key, int c) { return key * 128 + ((c ^ ((key >> 1) & 7)) << 4); }
__device__ __forceinline__ int v8_off(int n, int c) { return n * 64 + ((c ^ ((n >> 2) & 3)) << 4); }
template <bool WAITSTATES>
__device__ __forceinline__ void qkt8(f32x16& p0, f32x16& p1, const ATT_LAS char* Ks, const i32x8a (&q8)[2], int r32, int hi, int one) {
  p0 = f32x16{}; p1 = f32x16{};
  const i32x8a k00 = ld32(Ks + k8_off(r32, 2 * hi), Ks + k8_off(r32, 2 * hi + 1)), k10 = ld32(Ks + k8_off(32 + r32, 2 * hi), Ks + k8_off(32 + r32, 2 * hi + 1));
  const i32x8a k01 = ld32(Ks + k8_off(r32, 4 + 2 * hi), Ks + k8_off(r32, 5 + 2 * hi)), k11 = ld32(Ks + k8_off(32 + r32, 4 + 2 * hi), Ks + k8_off(32 + r32, 5 + 2 * hi));
  asm volatile("s_nop 1" ::: "memory");
  __builtin_amdgcn_s_setprio(1); MFMA8(p0, k00, q8[0], one); MFMA8(p1, k10, q8[0], one); MFMA8(p0, k01, q8[1], one); MFMA8(p1, k11, q8[1], one); __builtin_amdgcn_s_setprio(0);
  if (WAITSTATES) asm volatile("s_nop 15\n\ts_nop 7" ::: "memory");
}
template <bool WAITSTATES>
__device__ __forceinline__ void pv8(f32x16* o, const ATT_LAS char* Vs, const i32x8a& pa, int r32, int hi, int one) {
  const i32x8a v0 = ld32(Vs + v8_off(r32, 2 * hi), Vs + v8_off(r32, 2 * hi + 1)), v1 = ld32(Vs + v8_off(32 + r32, 2 * hi), Vs + v8_off(32 + r32, 2 * hi + 1));
  const i32x8a v2 = ld32(Vs + v8_off(64 + r32, 2 * hi), Vs + v8_off(64 + r32, 2 * hi + 1)), v3 = ld32(Vs + v8_off(96 + r32, 2 * hi), Vs + v8_off(96 + r32, 2 * hi + 1));
  __builtin_amdgcn_s_setprio(1); MFMA8(o[0], pa, v0, one); MFMA8(o[1], pa, v1, one); MFMA8(o[2], pa, v2, one); MFMA8(o[3], pa, v3, one); __builtin_amdgcn_s_setprio(0);
  if (WAITSTATES) asm volatile("s_nop 15\n\ts_nop 7" ::: "memory");
}
__device__ __forceinline__ void attn_unit8(const bf16_t* __restrict__ Qb, const unsigned char* __restrict__ K8h, const unsigned char* __restrict__ VT8h, unsigned char* __restrict__ Ob, int seq, ATT_LAS char* lds,
                                           const float* __restrict__ qg, const float* __restrict__ tab, int tpos0) {
  int tid_ = threadIdx.x; asm volatile("" : "+v"(tid_));
  const int tid = tid_, wid = tid >> 6, lane = tid & 63, r32 = lane & 31, hi = lane >> 5;
  int one = 0x7f7f7f7f; asm volatile("" : "+v"(one));
  ATT_LAS char* V_lds = lds; ATT_LAS char* K_lds = lds + 3 * 8192;
  ATT_LAS float* ws = (ATT_LAS float*)(lds + 6 * 8192) + wid * 64; ATT_LAS float* li_l = ws; ATT_LAS float* al_l = ws + 32;
  float m_reg = -1e30f, l_reg = 0; f32x16 o[4] = {}; i32x8a q8[2];
  const int krow = tid >> 3, kch = tid & 7, kst = k8_off(krow, kch), vst = v8_off(tid >> 2, tid & 3);
  const unsigned char* kg = K8h + (long)krow * 512 + kch * 16; const unsigned char* vg = VT8h + tid * 16;
  i32x4a sk[2], sv[2];
#define SLOAD8(i, t) do { sk[i] = *reinterpret_cast<const i32x4a*>(kg + (long)(t) * (64 * 512)); sv[i] = *reinterpret_cast<const i32x4a*>(vg + (long)(t) * VT_STRIDE); } while (0)
#define SWRITE8(b, i) do { *reinterpret_cast<ATT_LAS i32x4a*>(K_lds + (b) * 8192 + kst) = sk[i]; *reinterpret_cast<ATT_LAS i32x4a*>(V_lds + (b) * 8192 + vst) = sv[i]; } while (0)
#define SWAIT8() asm volatile("s_waitcnt vmcnt(2)" ::: "memory")
#define SWRITE8R(boff, i) do { *reinterpret_cast<ATT_LAS i32x4a*>(K_lds + (boff) + kst) = sk[i]; *reinterpret_cast<ATT_LAS i32x4a*>(V_lds + (boff) + vst) = sv[i]; } while (0)
#define RESC8(a) do { if (__any((a) < 1.f)) { if (hi == 0) al_l[r32] = (a); asm volatile("s_waitcnt lgkmcnt(0)" ::: "memory"); \
    _Pragma("unroll") for (int d = 0; d < 4; ++d) _Pragma("unroll") for (int r = 0; r < 16; ++r) o[d][r] *= al_l[crow(r, hi)]; } } while (0)
  const int NT = seq / KVBLK;
  SLOAD8(0, 0);
  {
    typedef float f32x4a __attribute__((ext_vector_type(4)));
    const bf16_t* Qw = Qb + (long)(wid * QBLK + r32) * LDQ + hi * 8;
    bf16x8 qr[8];
#pragma unroll
    for (int d0 = 0; d0 < 8; ++d0) qr[d0] = *reinterpret_cast<const bf16x8*>(Qw + d0 * 16);
    float x[8][8]; float ss = 0.f;
#pragma unroll
    for (int d0 = 0; d0 < 8; ++d0)
#pragma unroll
      for (int e = 0; e < 8; ++e) { x[d0][e] = __uint_as_float((unsigned)(unsigned short)qr[d0][e] << 16); ss += x[d0][e] * x[d0][e]; }
    { auto rr = __builtin_amdgcn_permlane32_swap(__float_as_uint(ss), __float_as_uint(ss), false, false); ss = __uint_as_float(rr[0]) + __uint_as_float(rr[1]); }
    const float inv = 1.0f / sqrtf(ss * (1.0f / 128.0f) + 1e-6f);
#pragma unroll
    for (int d0 = 0; d0 < 8; ++d0) { const f32x4a g0 = *reinterpret_cast<const f32x4a*>(qg + d0 * 16 + hi * 8), g1 = *reinterpret_cast<const f32x4a*>(qg + d0 * 16 + hi * 8 + 4);
#pragma unroll
      for (int e = 0; e < 4; ++e) { x[d0][e] = x[d0][e] * inv * g0[e]; x[d0][4 + e] = x[d0][4 + e] * inv * g1[e]; } }
    const int tq = tpos0 + wid * QBLK + r32;
#pragma unroll
    for (int ax = 0; ax < 2; ++ax) { const int pos = ax == 0 ? (tq >> 6) : (tq & 63);
#pragma unroll
      for (int h = 0; h < 2; ++h) { const f32x4a* tp = reinterpret_cast<const f32x4a*>(tab + (size_t)(pos * 32 + h * 16 + hi * 8) * 2);
#pragma unroll
        for (int e2 = 0; e2 < 4; ++e2) { const f32x4a cs = tp[e2];
#pragma unroll
          for (int k = 0; k < 2; ++k) { const int e = 2 * e2 + k; const float c = cs[2 * k], s = cs[2 * k + 1]; const float u0 = x[ax * 4 + h][e], u1 = x[ax * 4 + 2 + h][e];
            x[ax * 4 + h][e] = u0 * c - u1 * s; x[ax * 4 + 2 + h][e] = u1 * c + u0 * s; } } } }
#pragma unroll
    for (int s = 0; s < 2; ++s)
      q8[s] = (i32x8a){(int)pk4f8(x[4 * s][0], x[4 * s][1], x[4 * s][2], x[4 * s][3]), (int)pk4f8(x[4 * s][4], x[4 * s][5], x[4 * s][6], x[4 * s][7]),
                       (int)pk4f8(x[4 * s + 1][0], x[4 * s + 1][1], x[4 * s + 1][2], x[4 * s + 1][3]), (int)pk4f8(x[4 * s + 1][4], x[4 * s + 1][5], x[4 * s + 1][6], x[4 * s + 1][7]),
                       (int)pk4f8(x[4 * s + 2][0], x[4 * s + 2][1], x[4 * s + 2][2], x[4 * s + 2][3]), (int)pk4f8(x[4 * s + 2][4], x[4 * s + 2][5], x[4 * s + 2][6], x[4 * s + 2][7]),
                       (int)pk4f8(x[4 * s + 3][0], x[4 * s + 3][1], x[4 * s + 3][2], x[4 * s + 3][3]), (int)pk4f8(x[4 * s + 3][4], x[4 * s + 3][5], x[4 * s + 3][6], x[4 * s + 3][7])};
  }
  f32x16 pA0, pA1, pB0, pB1; float mnA, mnB, alA, alB; i32x8a pa;
  asm volatile("s_waitcnt vmcnt(0)" ::: "memory"); SWRITE8(0, 0); __syncthreads();
  qkt8<true>(pA0, pA1, K_lds, q8, r32, hi, one); partialSM8(pA0, pA1, m_reg, mnA, alA);
  SLOAD8(1, 1); if (2 < NT) SLOAD8(0, 2);
  SWAIT8(); SWRITE8(1, 1); __syncthreads();
  int bK = 8192, bV = 0, bW = 2 * 8192;
  for (int j = 1; j + 1 < NT; j += 2) {
    SBAR(); qkt8<false>(pB0, pB1, K_lds + bK, q8, r32, hi, one);
    finishSM8(pA0, pA1, alA, l_reg, pa); SBAR();
    SLOAD8(1, j + 2); SBAR();
    pv8<false>(o, V_lds + bV, pa, r32, hi, one); partialSM8(pB0, pB1, m_reg, mnB, alB);
    SWAIT8(); SWRITE8R(bW, 0);
    RESC8(alB); __syncthreads();
    { const int t = bV; bV = bK; bK = bW; bW = t; }
    SBAR(); qkt8<false>(pA0, pA1, K_lds + bK, q8, r32, hi, one);
    finishSM8(pB0, pB1, alB, l_reg, pa); SBAR();
    if (j + 3 < NT) SLOAD8(0, j + 3); SBAR();
    pv8<false>(o, V_lds + bV, pa, r32, hi, one); partialSM8(pA0, pA1, m_reg, mnA, alA);
    SWAIT8(); SWRITE8R(bW, 1);
    RESC8(alA); __syncthreads();
    { const int t = bV; bV = bK; bK = bW; bW = t; }
  }
  SBAR(); qkt8<false>(pB0, pB1, K_lds + bK, q8, r32, hi, one);
  finishSM8(pA0, pA1, alA, l_reg, pa); SBAR();
  pv8<false>(o, V_lds + bV, pa, r32, hi, one); partialSM8(pB0, pB1, m_reg, mnB, alB);
  RESC8(alB);
  finishSM8(pB0, pB1, alB, l_reg, pa); SBAR();
  pv8<true>(o, V_lds + bK, pa, r32, hi, one);
  if (hi == 0) li_l[r32] = l_reg; asm volatile("s_waitcnt lgkmcnt(0)" ::: "memory");
  float rli[16];
#pragma unroll
  for (int r = 0; r < 16; ++r) rli[r] = __builtin_amdgcn_rcpf(li_l[crow(r, hi)]);
  unsigned char* Ow = Ob + (long)(wid * QBLK) * LDO;
  ATT_LAS unsigned char* ot = (ATT_LAS unsigned char*)lds + 65536 + wid * (32 * 144);
#pragma unroll
  for (int r = 0; r < 16; ++r) { const int orow = crow(r, hi);
#pragma unroll
    for (int d0 = 0; d0 < 4; ++d0) { const float xo = o[d0][r] * rli[r] * O8SCALE; ot[orow * 144 + d0 * 32 + r32] = (unsigned char)(__builtin_amdgcn_cvt_pk_fp8_f32(xo, xo, 0, false) & 0xff); } }
  asm volatile("s_waitcnt lgkmcnt(0)" ::: "memory");
#pragma unroll
  for (int k = 0; k < 4; ++k) { const int p = lane + 64 * k, row = p >> 3, c = p & 7;
    const i32x4a v = *reinterpret_cast<const ATT_LAS i32x4a*>(ot + row * 144 + c * 16);
    *reinterpret_cast<i32x4a*>(Ow + (long)row * LDO + c * 16) = v; }
  __syncthreads();
#undef SLOAD8
#undef SWRITE8
#undef SWAIT8
#undef RESC8
}
}

constexpr int NWAVES = 8;
constexpr int DM = 4096, T_P = 16384, T_ALL = 24576, SEQ_P = 2048, SEQ_S = 4096;
constexpr int NQ = 2048, NKV = 512, NU = 2048, INW = 13312, DFF = 11008, NUP = 22016;
constexpr float EPS = 1e-6f;
constexpr size_t MiB = 1u << 20;
constexpr size_t WS_CTL = 0, CTL_ZERO_BYTES = 1 * MiB;
constexpr size_t WS_ROPE = 1 * MiB;
constexpr size_t WS_WIN = 2 * MiB;
constexpr size_t WS_WDOWN = WS_WIN;
constexpr size_t WS_WATT = 106 * MiB;
constexpr size_t WS_WPOOL = 122 * MiB;
constexpr size_t WS_WOUT = 126 * MiB;
constexpr size_t WS_WUP = 158 * MiB;
constexpr size_t WS_R1 = 330 * MiB;
constexpr size_t WS_D = WS_R1, WS_O = WS_R1 + 96 * MiB;
constexpr size_t WS_Q = 522 * MiB, WS_K = 618 * MiB, WS_V = 642 * MiB, WS_U = 666 * MiB, WS_SA = 762 * MiB, WS_SP = 954 * MiB;
constexpr size_t WS_ACT = 522 * MiB;
constexpr size_t WS_HB = 1038 * MiB;
constexpr size_t WS_END = 1146 * MiB;
static_assert(WS_WIN + (size_t)INW * DM * 2 == WS_WATT && WS_WUP + (size_t)NUP * DM * 2 == WS_R1 && WS_R1 + (size_t)T_ALL * DM * 2 == WS_Q, "ws map");
static_assert(WS_SP + (size_t)T_ALL * DM * 2 == WS_END && WS_ACT + (size_t)T_ALL * DFF * 2 == WS_HB && WS_HB + (size_t)96 * 4 * NUP * 4 <= WS_END, "ws map 2");
static_assert(WS_WDOWN + (size_t)DM * DFF * 2 <= WS_WATT, "ws map 3");
constexpr size_t WS_WIN8 = WS_WIN + 16 * MiB;
constexpr size_t N8_OFF = (size_t)DM * DFF * 2;
constexpr int I_DOWN_TAIL = 10240;
constexpr size_t WS_K8 = WS_O + 48 * MiB;
constexpr size_t WS_VT8 = WS_O + 60 * MiB;
constexpr int CW_BAR = 4096;
constexpr size_t CTL_TAILF = 262144;
constexpr size_t CTL_SSQ1 = 65536;
constexpr int RING_OFF = 0, RING_BYTES = 131072;
constexpr int LDSCTL_OFF = RING_BYTES, MISC_OFF = LDSCTL_OFF + 320;
constexpr int LDS_BYTES = 147456;

#define GAS __attribute__((address_space(1)))
#define LAS __attribute__((address_space(3)))
typedef unsigned short bf16;
typedef unsigned v4u __attribute__((ext_vector_type(4)));
typedef unsigned v2u __attribute__((ext_vector_type(2)));
typedef float f32x4 __attribute__((ext_vector_type(4)));
typedef float f32x2 __attribute__((ext_vector_type(2)));
typedef GAS unsigned gu32;
#define RLX_AGENT __ATOMIC_RELAXED, __HIP_MEMORY_SCOPE_AGENT
#define LDS_WAIT() asm volatile("s_waitcnt lgkmcnt(0)" ::: "memory")
#define VM_WAIT() asm volatile("s_waitcnt vmcnt(0)" ::: "memory")
__device__ __forceinline__ unsigned pk2(float lo, float hi) { return pg8::cvt_pk_bf16(lo, hi); }
__device__ __forceinline__ float bflo(unsigned w) { return __uint_as_float(w << 16); }
__device__ __forceinline__ float bfhi(unsigned w) { return __uint_as_float(w & 0xffff0000u); }

#define XB_TMO      128
#define XB_XCNT(j)  (256  + 64 * (j))
#define XB_XSUB(j)  (1280 + 64 * (j))
#define XB_XGEN(j)  (2304 + 64 * (j))
#define XB_TOP      3328
#define XB_TOPGEN   3392
#define XCD_BAR_WORDS 3456
#define XB_SPIN_CAP (1u << 18)
__device__ __forceinline__ unsigned xb_ld(unsigned* p)              { return __hip_atomic_load(p, __ATOMIC_RELAXED, __HIP_MEMORY_SCOPE_AGENT); }
__device__ __forceinline__ unsigned xb_add(unsigned* p, unsigned v) { return __hip_atomic_fetch_add(p, v, __ATOMIC_RELAXED, __HIP_MEMORY_SCOPE_AGENT); }
__device__ __forceinline__ unsigned xb_xcc_id() { return (unsigned)__builtin_amdgcn_s_getreg((3 << 11) | 20) & 0xFu; }
#define XB_SPIN(cond, bar) do { unsigned _sp = 0; while (cond) { __builtin_amdgcn_s_sleep(1); \
    if ((++_sp & 255u) == 0u) { if (xb_ld(&(bar)[XB_TMO])) break; if (_sp > XB_SPIN_CAP) { atomicAdd(&(bar)[XB_TMO], 1u); break; } } } } while (0)

namespace pg8 {
struct EpiConvGluTail {
    static constexpr bool PERM = true, AFTER_DRAIN = false, USES_LDS = true, HALF_OK = false;
    EpiConvGlu inner; float* part; unsigned* flag; unsigned* bar; int kpart, slot;
    __device__ __forceinline__ void run(f32x4 (&acc)[2][2][4][2], const Unit& un, int wr, int wc, int fr, int fq, PG8_LAS unsigned char* xl) const {
        int t = wr * 256 + wc * 64 + fq * 16 + fr; asm volatile("" : "+v"(t));
        if (kpart != 0) {
            PG8_GAS f32x4* dst = (PG8_GAS f32x4*)(part + ((size_t)(slot * 3 + kpart - 1) << 16)) + t;
#pragma unroll
            for (int ai = 0; ai < 2; ++ai)
#pragma unroll
                for (int bj = 0; bj < 2; ++bj)
#pragma unroll
                    for (int m = 0; m < 4; ++m)
#pragma unroll
                        for (int n = 0; n < 2; ++n) dst[(((ai * 2 + bj) * 4 + m) * 2 + n) * 512] = acc[ai][bj][m][n];
            asm volatile("s_waitcnt vmcnt(0)" ::: "memory"); __builtin_amdgcn_s_barrier();
            if (t == 0) { __builtin_amdgcn_fence(__ATOMIC_RELEASE, "agent"); asm volatile("s_waitcnt vmcnt(0)" ::: "memory"); (void)xb_add(flag + slot * 16, 1u); }
        } else {
            if (t == 0) { XB_SPIN(xb_ld(flag + slot * 16) < 3u, bar); __builtin_amdgcn_fence(__ATOMIC_ACQUIRE, "agent"); }
            asm volatile("s_waitcnt vmcnt(0)" ::: "memory"); __builtin_amdgcn_s_barrier(); asm volatile("" ::: "memory");
#pragma unroll
            for (int p = 0; p < 3; ++p) {
                const PG8_GAS f32x4* src = (const PG8_GAS f32x4*)(part + ((size_t)(slot * 3 + p) << 16)) + t;
#pragma unroll
                for (int ai = 0; ai < 2; ++ai)
#pragma unroll
                    for (int bj = 0; bj < 2; ++bj) {
                        f32x4 v[4][2];
#pragma unroll
                        for (int m = 0; m < 4; ++m)
#pragma unroll
                            for (int n = 0; n < 2; ++n) v[m][n] = src[(((ai * 2 + bj) * 4 + m) * 2 + n) * 512];
                        __builtin_amdgcn_sched_barrier(0);
#pragma unroll
                        for (int m = 0; m < 4; ++m)
#pragma unroll
                            for (int n = 0; n < 2; ++n) { acc[ai][bj][m][n] += v[m][n]; asm volatile("" : "+v"(acc[ai][bj][m][n])); }
                        __builtin_amdgcn_sched_barrier(0);
                    }
            }
            inner.run(acc, un, wr, wc, fr, fq, xl);
        }
    }
};
}

struct XcdBarrier {
    unsigned* bar; unsigned x;
    volatile LAS unsigned* st;
};

__device__ __forceinline__ XcdBarrier xcd_barrier_post(unsigned* bar, volatile LAS unsigned* st) {
    XcdBarrier b; b.bar = bar; b.x = xb_xcc_id(); b.st = st;
    if (threadIdx.x == 0) (void)xb_add(&bar[XB_XCNT(b.x)], 1u);
    return b;
}
__device__ __forceinline__ void xcd_barrier_complete(unsigned* bar, unsigned x, unsigned& nloc, unsigned& nx) {
    const unsigned G = gridDim.x * gridDim.y * gridDim.z;
    unsigned sum, cnt, mine, sp = 0u;
    for (;;) {
        sum = 0u; cnt = 0u; mine = 0u;
#pragma unroll
        for (unsigned j = 0; j < 16; ++j) { const unsigned c = xb_ld(&bar[XB_XCNT(j)]); sum += c; cnt += (c > 0u) ? 1u : 0u; mine = (j == x) ? c : mine; }
        if (sum == G) break;
        __builtin_amdgcn_s_sleep(1);
        if ((++sp & 255u) == 0u) { if (xb_ld(&bar[XB_TMO])) break; if (sp > XB_SPIN_CAP) { atomicAdd(&bar[XB_TMO], 1u); break; } }
    }
    nloc = mine > 0u ? mine : 1u; nx = cnt > 0u ? cnt : 1u;
}

__device__ __forceinline__ void xcd_barrier(const XcdBarrier& b) {
    asm volatile("s_waitcnt vmcnt(0)" ::: "memory");
    __syncthreads();
    if (threadIdx.x == 0) {
        unsigned* bar = b.bar;
        __builtin_amdgcn_s_waitcnt(0);
        unsigned nloc = b.st[0], nx = b.st[1];
        if (nloc == 0u) { xcd_barrier_complete(bar, b.x, nloc, nx); b.st[0] = nloc; b.st[1] = nx; }
        const unsigned old = xb_add(&bar[XB_XSUB(b.x)], 1u);
        const unsigned gen = old / nloc;
        if (old + 1u == (gen + 1u) * nloc) {
            __builtin_amdgcn_fence(__ATOMIC_RELEASE, "agent");
            asm volatile("s_waitcnt vmcnt(0)" ::: "memory");
            const unsigned og = xb_add(&bar[XB_TOP], 1u);
            const unsigned tg = og / nx;
            if (og + 1u == (tg + 1u) * nx) xb_add(&bar[XB_TOPGEN], 1u);
            else XB_SPIN(xb_ld(&bar[XB_TOPGEN]) == tg, bar);
            __builtin_amdgcn_fence(__ATOMIC_ACQUIRE, "agent");
            xb_add(&bar[XB_XGEN(b.x)], 1u);
            asm volatile("s_waitcnt vmcnt(0)" ::: "memory");
        } else {
            XB_SPIN(xb_ld(&bar[XB_XGEN(b.x)]) == gen, bar);
            __builtin_amdgcn_fence(__ATOMIC_ACQUIRE, "agent");
            asm volatile("s_waitcnt vmcnt(0)" ::: "memory");
        }
    }
    __syncthreads();
}

__device__ __forceinline__ float wave_sum(float v) {
#pragma unroll
    for (int o = 1; o < 64; o <<= 1) v += __shfl_xor(v, o);
    return v;
}
template <bool UPMAP = false>
__device__ __forceinline__ void transpose_item(const float* W, int K, int N, bf16* WT, int ldk, int row_off, LAS float* scr, int item, int lane, const float* kscale = nullptr) {
    const int nblk = N / 32, kb = item / nblk, nb = item % nblk, k0 = 64 * kb, n0 = 32 * nb;
    const int drow0 = UPMAP ? (n0 < DFF ? (n0 >> 7) * 256 + (n0 & 127) : ((n0 - DFF) >> 7) * 256 + 128 + ((n0 - DFF) & 127)) : row_off + n0;
    f32x4 wv[8]; const int kr = lane >> 3, nq = (lane & 7) * 4;
#pragma unroll
    for (int i = 0; i < 8; ++i) wv[i] = *(const GAS f32x4*)(W + (size_t)(k0 + 8 * i + kr) * N + n0 + nq);
#pragma unroll
    for (int i = 0; i < 8; ++i) { const int kk = 8 * i + kr; f32x4 w = wv[i]; if (kscale) w = w * kscale[k0 + kk];
        LAS float* d = scr + kk * 33 + nq; d[0] = w.x; d[1] = w.y; d[2] = w.z; d[3] = w.w; }
    LDS_WAIT(); asm volatile("" ::: "memory");
    const int c = lane & 7;
#pragma unroll
    for (int j = 0; j < 4; ++j) { const int n = (lane >> 3) + 8 * j; const LAS float* s = scr + (8 * c) * 33 + n;
        v4u o; o.x = pk2(s[0 * 33], s[1 * 33]); o.y = pk2(s[2 * 33], s[3 * 33]); o.z = pk2(s[4 * 33], s[5 * 33]); o.w = pk2(s[6 * 33], s[7 * 33]);
        *(GAS v4u*)(WT + (size_t)(drow0 + n) * ldk + k0 + 8 * c) = o; }
    LDS_WAIT(); asm volatile("" ::: "memory");
}
constexpr float W8SCALE = 64.0f;
__device__ __forceinline__ unsigned pk4_fp8(float a, float b, float c, float d) { unsigned w = 0u; w = __builtin_amdgcn_cvt_pk_fp8_f32(a, b, w, false); w = __builtin_amdgcn_cvt_pk_fp8_f32(c, d, w, true); return w; }
__device__ __forceinline__ void transpose_item_in(const float* W, bf16* WTu, unsigned char* WT8, LAS float* scr, int item, int lane) {
    constexpr int K = DM, N = INW;
    const int nblk = N / 32, kb = item / nblk, nb = item % nblk, k0 = 64 * kb, n0 = 32 * nb;
    f32x4 wv[8]; const int kr = lane >> 3, nq = (lane & 7) * 4;
#pragma unroll
    for (int i = 0; i < 8; ++i) wv[i] = *(const GAS f32x4*)(W + (size_t)(k0 + 8 * i + kr) * N + n0 + nq);
#pragma unroll
    for (int i = 0; i < 8; ++i) { const int kk = 8 * i + kr; const f32x4 w = wv[i]; LAS float* d = scr + kk * 33 + nq; d[0] = w.x; d[1] = w.y; d[2] = w.z; d[3] = w.w; }
    LDS_WAIT(); asm volatile("" ::: "memory");
    const int c = lane & 7;
    if (n0 >= 3072 && n0 < 5120) {
#pragma unroll
        for (int j = 0; j < 4; ++j) { const int n = (lane >> 3) + 8 * j; const LAS float* s = scr + (8 * c) * 33 + n;
            v4u o; o.x = pk2(s[0 * 33], s[1 * 33]); o.y = pk2(s[2 * 33], s[3 * 33]); o.z = pk2(s[4 * 33], s[5 * 33]); o.w = pk2(s[6 * 33], s[7 * 33]);
            *(GAS v4u*)(WTu + (size_t)(n0 - 3072 + n) * K + k0 + 8 * c) = o; }
    } else {
        const int r0 = n0 < 3072 ? n0 : n0 - 2048;
#pragma unroll
        for (int j = 0; j < 4; ++j) { const int n = (lane >> 3) + 8 * j; const LAS float* s = scr + (8 * c) * 33 + n;
            v2u o; o.x = pk4_fp8(s[0 * 33] * W8SCALE, s[1 * 33] * W8SCALE, s[2 * 33] * W8SCALE, s[3 * 33] * W8SCALE); o.y = pk4_fp8(s[4 * 33] * W8SCALE, s[5 * 33] * W8SCALE, s[6 * 33] * W8SCALE, s[7 * 33] * W8SCALE);
            *(GAS v2u*)(WT8 + (size_t)(r0 + n) * K + k0 + 8 * c) = o; }
    }
    LDS_WAIT(); asm volatile("" ::: "memory");
}
__device__ __forceinline__ void transpose_item_f8(const float* W, int K, int N, unsigned char* WT8, int ldk, LAS float* scr, int item, int lane) {
    const int nblk = N / 32, kb = item / nblk, nb = item % nblk, k0 = 64 * kb, n0 = 32 * nb;
    f32x4 wv[8]; const int kr = lane >> 3, nq = (lane & 7) * 4;
#pragma unroll
    for (int i = 0; i < 8; ++i) wv[i] = *(const GAS f32x4*)(W + (size_t)(k0 + 8 * i + kr) * N + n0 + nq);
#pragma unroll
    for (int i = 0; i < 8; ++i) { const int kk = 8 * i + kr; const f32x4 w = wv[i]; LAS float* d = scr + kk * 33 + nq; d[0] = w.x; d[1] = w.y; d[2] = w.z; d[3] = w.w; }
    LDS_WAIT(); asm volatile("" ::: "memory");
    const int c = lane & 7;
#pragma unroll
    for (int j = 0; j < 4; ++j) { const int n = (lane >> 3) + 8 * j; const LAS float* s = scr + (8 * c) * 33 + n;
        v2u o; o.x = pk4_fp8(s[0 * 33] * W8SCALE, s[1 * 33] * W8SCALE, s[2 * 33] * W8SCALE, s[3 * 33] * W8SCALE); o.y = pk4_fp8(s[4 * 33] * W8SCALE, s[5 * 33] * W8SCALE, s[6 * 33] * W8SCALE, s[7 * 33] * W8SCALE);
        *(GAS v2u*)(WT8 + (size_t)(n0 + n) * ldk + k0 + 8 * c) = o; }
    LDS_WAIT(); asm volatile("" ::: "memory");
}
__device__ __forceinline__ void rms_row_to_bf16(const float* xrow, const float* g, bf16* orow, int lane, unsigned char* o8row = nullptr) {
    const GAS f32x4* xr = (const GAS f32x4*)xrow + lane;
    f32x4 v[16]; float s = 0.f;
#pragma unroll
    for (int j = 0; j < 16; ++j) { v[j] = xr[64 * j]; s += (v[j].x * v[j].x + v[j].y * v[j].y) + (v[j].z * v[j].z + v[j].w * v[j].w); }
    const float inv = 1.0f / sqrtf(wave_sum(s) * (1.f / DM) + EPS);
    const GAS f32x4* gr = (const GAS f32x4*)g + lane;
    GAS v2u* o8 = (GAS v2u*)orow + lane;
#pragma unroll
    for (int j = 0; j < 16; ++j) { const f32x4 gg = gr[64 * j]; const float a = v[j].x * inv * gg.x, b = v[j].y * inv * gg.y, c = v[j].z * inv * gg.z, d = v[j].w * inv * gg.w;
        v2u w; w.x = pk2(a, b); w.y = pk2(c, d); o8[64 * j] = w;
        if (o8row) ((GAS unsigned*)o8row)[lane + 64 * j] = pk4_fp8(a, b, c, d); }
}
__device__ __forceinline__ void rms_row_bf16_to_f32(const bf16* hrow, const float* g, float* orow, int lane) {
    const GAS v4u* hr = (const GAS v4u*)hrow + lane;
    v4u v[8]; float s = 0.f;
#pragma unroll
    for (int j = 0; j < 8; ++j) { v[j] = hr[64 * j];
        const float a0 = bflo(v[j].x), a1 = bfhi(v[j].x), a2 = bflo(v[j].y), a3 = bfhi(v[j].y), a4 = bflo(v[j].z), a5 = bfhi(v[j].z), a6 = bflo(v[j].w), a7 = bfhi(v[j].w);
        s += ((a0 * a0 + a1 * a1) + (a2 * a2 + a3 * a3)) + ((a4 * a4 + a5 * a5) + (a6 * a6 + a7 * a7)); }
    const float inv = 1.0f / sqrtf(wave_sum(s) * (1.f / DM) + EPS);
#pragma unroll
    for (int j = 0; j < 8; ++j) { const int c = 512 * j + 8 * lane; const f32x4 g0 = *(const GAS f32x4*)(g + c), g1 = *(const GAS f32x4*)(g + c + 4);
        f32x4 o0, o1; o0.x = bflo(v[j].x) * inv * g0.x; o0.y = bfhi(v[j].x) * inv * g0.y; o0.z = bflo(v[j].y) * inv * g0.z; o0.w = bfhi(v[j].y) * inv * g0.w;
        o1.x = bflo(v[j].z) * inv * g1.x; o1.y = bfhi(v[j].z) * inv * g1.y; o1.z = bflo(v[j].w) * inv * g1.z; o1.w = bfhi(v[j].w) * inv * g1.w;
        *(GAS f32x4*)(orow + c) = o0; *(GAS f32x4*)(orow + c + 4) = o1; }
}
__device__ __forceinline__ void rms_row_inplace(float* xrow, const float* g, int lane) {
    GAS f32x4* xr = (GAS f32x4*)xrow + lane;
    f32x4 v[16]; float s = 0.f;
#pragma unroll
    for (int j = 0; j < 16; ++j) { v[j] = xr[64 * j]; s += (v[j].x * v[j].x + v[j].y * v[j].y) + (v[j].z * v[j].z + v[j].w * v[j].w); }
    const float inv = 1.0f / sqrtf(wave_sum(s) * (1.f / DM) + EPS);
    const GAS f32x4* gr = (const GAS f32x4*)g + lane;
#pragma unroll
    for (int j = 0; j < 16; ++j) { const f32x4 gg = gr[64 * j]; xr[64 * j] = v[j] * inv * gg; }
}
__device__ __forceinline__ void seq_pos(int m, int& t, int& S) { if (m < T_P) { t = m & (SEQ_P - 1); S = SEQ_P; } else { t = (m - T_P) & (SEQ_S - 1); S = SEQ_S; } }

template <int NB>
__device__ __forceinline__ void normrope_items(bf16* QB, bf16* KB, const float* qg, const float* kg, const f32x2* tab, int it0, int stride, int nitems, int lane, unsigned char* K8) {
    const int hh = lane >> 4, j = lane & 15, a = j >> 3, i0 = (j & 7) * 4;
    GAS v2u* p0[NB]; GAS v2u* p1[NB]; v2u w0[NB], w1[NB]; int tt[NB], mm[NB]; bool isq[NB], ok[NB];
#pragma unroll
    for (int b = 0; b < NB; ++b) { const int it = it0 + b * stride; ok[b] = it < nitems; const int itc = ok[b] ? it : it0; const int m = itc, s = 4; int t, S_; seq_pos(m, t, S_); tt[b] = t; mm[b] = m; isq[b] = s < 4;
        bf16* p4 = isq[b] ? QB + (size_t)m * NQ + s * 512 : KB + (size_t)m * NKV;
        p0[b] = (GAS v2u*)(p4 + hh * 128 + a * 64 + i0); p1[b] = (GAS v2u*)(p4 + hh * 128 + a * 64 + 32 + i0); w0[b] = *p0[b]; w1[b] = *p1[b]; }
#pragma unroll
    for (int b = 0; b < NB; ++b) {
        float x0[4] = {bflo(w0[b].x), bfhi(w0[b].x), bflo(w0[b].y), bfhi(w0[b].y)}, x1[4] = {bflo(w1[b].x), bfhi(w1[b].x), bflo(w1[b].y), bfhi(w1[b].y)};
        float ss = 0.f;
#pragma unroll
        for (int c = 0; c < 4; ++c) ss += x0[c] * x0[c] + x1[c] * x1[c];
        ss += __shfl_xor(ss, 1); ss += __shfl_xor(ss, 2); ss += __shfl_xor(ss, 4); ss += __shfl_xor(ss, 8);
        const float inv = 1.0f / sqrtf(ss * (1.f / 128.f) + EPS);
        const int pos = a == 0 ? (tt[b] >> 6) : (tt[b] & 63);
        const float* g = isq[b] ? qg : kg;
        const f32x4 g0 = *(const GAS f32x4*)(g + a * 64 + i0), g1 = *(const GAS f32x4*)(g + a * 64 + 32 + i0);
        float y0[4], y1[4];
#pragma unroll
        for (int c = 0; c < 4; ++c) { const f32x2 cs = tab[pos * 32 + i0 + c]; const float u0 = x0[c] * inv * g0[c], u1 = x1[c] * inv * g1[c]; y0[c] = u0 * cs.x - u1 * cs.y; y1[c] = u1 * cs.x + u0 * cs.y; }
        v2u o0, o1; o0.x = pk2(y0[0], y0[1]); o0.y = pk2(y0[2], y0[3]); o1.x = pk2(y1[0], y1[1]); o1.y = pk2(y1[2], y1[3]);
        if (ok[b]) {
            GAS unsigned char* kr = (GAS unsigned char*)K8 + (size_t)mm[b] * NKV + hh * 128 + a * 64 + ((i0 >> 3) & 1) * 32 + (i0 >> 4) * 8 + (i0 & 7);
            *(GAS unsigned*)kr = pk4_fp8(y0[0], y0[1], y0[2], y0[3]); *(GAS unsigned*)(kr + 16) = pk4_fp8(y1[0], y1[1], y1[2], y1[3]); }
    }
}
__device__ __forceinline__ void vt_block(const bf16* VB, unsigned char* VT8, int blk, int kvh, LAS unsigned char* scr, int lane) {
    const bf16* src = VB + (size_t)blk * 64 * NKV + kvh * 128;
    v4u x[16];
#pragma unroll
    for (int i = 0; i < 16; ++i) { const int ci = i * 64 + lane; x[i] = *(const GAS v4u*)(src + (size_t)(ci >> 4) * NKV + (ci & 15) * 8); }
#pragma unroll
    for (int i = 0; i < 16; ++i) { const int ci = i * 64 + lane, tok = ci >> 4, dch = ci & 15, s = tok >> 5, c = tok & 31, pos = ((c >> 2) & 1) * 32 + s * 16 + (c & 3) + 4 * (c >> 3);
        const unsigned w0 = __builtin_amdgcn_cvt_pk_fp8_f32(bflo(x[i].x), bfhi(x[i].x), 0, false), w1 = __builtin_amdgcn_cvt_pk_fp8_f32(bflo(x[i].y), bfhi(x[i].y), 0, false);
        const unsigned w2 = __builtin_amdgcn_cvt_pk_fp8_f32(bflo(x[i].z), bfhi(x[i].z), 0, false), w3 = __builtin_amdgcn_cvt_pk_fp8_f32(bflo(x[i].w), bfhi(x[i].w), 0, false);
        LAS unsigned char* d = scr + (dch * 8) * 64 + pos;
        d[0 * 64] = (unsigned char)w0; d[1 * 64] = (unsigned char)(w0 >> 8); d[2 * 64] = (unsigned char)w1; d[3 * 64] = (unsigned char)(w1 >> 8);
        d[4 * 64] = (unsigned char)w2; d[5 * 64] = (unsigned char)(w2 >> 8); d[6 * 64] = (unsigned char)w3; d[7 * 64] = (unsigned char)(w3 >> 8); }
    LDS_WAIT(); asm volatile("" ::: "memory");
    unsigned char* dst = VT8 + (size_t)(blk * 4 + kvh) * 8192;
#pragma unroll
    for (int i = 0; i < 8; ++i) *(GAS v4u*)(dst + (i * 64 + lane) * 16) = *(const LAS v4u*)(scr + (i * 64 + lane) * 16);
    LDS_WAIT(); asm volatile("" ::: "memory");
}
constexpr int PSEG = 32;
template <int W>
__device__ __forceinline__ void pool_seg(const bf16* u, bf16* d, int m0  , int grp, int lane) {
    int t0, S; seq_pos(m0, t0, S);
    const bf16* base = u + (size_t)(m0 - t0) * NU + grp * 512 + lane * 8;
    bf16* dbase = d + (size_t)(m0 - t0) * NU + grp * 512 + lane * 8;
    v4u ring[W]; float sum[8] = {0.f, 0.f, 0.f, 0.f, 0.f, 0.f, 0.f, 0.f};
    const v4u z = {0u, 0u, 0u, 0u};
#define POOL_ADD(vv_, sgn) do { const v4u q_ = (vv_); sum[0] += sgn bflo(q_.x); sum[1] += sgn bfhi(q_.x); sum[2] += sgn bflo(q_.y); sum[3] += sgn bfhi(q_.y); sum[4] += sgn bflo(q_.z); sum[5] += sgn bfhi(q_.z); sum[6] += sgn bflo(q_.w); sum[7] += sgn bfhi(q_.w); } while (0)
#pragma unroll
    for (int i = 0; i < W - 1; ++i) { const int r = t0 - W / 2 + i; const v4u x = (r >= 0 && r < S) ? *(const GAS v4u*)(base + (size_t)r * NU) : z; ring[(W - W / 2 + i) % W] = x; }
#pragma unroll
    for (int i = 0; i < W - 1; ++i) POOL_ADD(ring[(W - W / 2 + i) % W], +);
    ring[(W / 2 - 1) % W] = z;
#pragma unroll 1
    for (int b = 0; b < PSEG; b += 16) {
        v4u nw[16];
#pragma unroll
        for (int s = 0; s < 16; ++s) { const int r = t0 + b + s + W / 2 - 1; nw[s] = (r >= 0 && r < S) ? *(const GAS v4u*)(base + (size_t)r * NU) : z; }
#pragma unroll
        for (int s = 0; s < 16; ++s) { const int t = t0 + b + s;
            const int slot = (s + W / 2 - 1) % W;
            POOL_ADD(ring[slot], -); ring[slot] = nw[s]; POOL_ADD(nw[s], +);
            const int lo = t - W / 2 < 0 ? 0 : t - W / 2, hi = t + W / 2 > S ? S : t + W / 2; const float rc = 1.0f / (float)(hi - lo);
            const v4u c = ring[s % W];
            v4u o; o.x = pk2(sum[0] * rc - bflo(c.x), sum[1] * rc - bfhi(c.x)); o.y = pk2(sum[2] * rc - bflo(c.y), sum[3] * rc - bfhi(c.y));
            o.z = pk2(sum[4] * rc - bflo(c.z), sum[5] * rc - bfhi(c.z)); o.w = pk2(sum[6] * rc - bflo(c.w), sum[7] * rc - bfhi(c.w));
            *(GAS v4u*)(dbase + (size_t)t * NU) = o; }
    }
#undef POOL_ADD
}
__device__ __forceinline__ float silu_f(float x) { return x * __builtin_amdgcn_rcpf(1.0f + __builtin_amdgcn_exp2f(-1.4426950408889634f * x)); }
__device__ __forceinline__ void fixup_item(const float* hb, bf16* act, const float* cw, const float* cb, int pm, int which, int colg, int lane) {
    const int j0 = colg * 512 + lane * 8;
    if (j0 >= DFF) return;
    const int row = pm * 256 + (which ? 255 : 0); int t, S; seq_pos(row, t, S);
    const size_t tc = (size_t)(j0 >> 7) * 256 + (j0 & 127);
    const float* hp = which ? hb + ((size_t)pm * 4 + 2) * NUP : (t > 0 ? hb + ((size_t)(pm - 1) * 4 + 3) * NUP : nullptr);
    const float* hc = hb + ((size_t)pm * 4 + (which ? 3 : 0)) * NUP;
    const float* hn = which ? (t < S - 1 ? hb + ((size_t)(pm + 1) * 4 + 0) * NUP : nullptr) : hb + ((size_t)pm * 4 + 1) * NUP;
    float o[8];
#pragma unroll
    for (int q = 0; q < 2; ++q) {
        const int j = j0 + 4 * q; const size_t p = tc + 4 * q; const f32x4 z = {0.f, 0.f, 0.f, 0.f};
        const f32x4 gp = hp ? *(const GAS f32x4*)(hp + p) : z, vp = hp ? *(const GAS f32x4*)(hp + p + 128) : z;
        const f32x4 gc = *(const GAS f32x4*)(hc + p), vc = *(const GAS f32x4*)(hc + p + 128);
        const f32x4 gn = hn ? *(const GAS f32x4*)(hn + p) : z, vn = hn ? *(const GAS f32x4*)(hn + p + 128) : z;
        const f32x4 w0g = *(const GAS f32x4*)(cw + j), w1g = *(const GAS f32x4*)(cw + NUP + j), w2g = *(const GAS f32x4*)(cw + 2 * (size_t)NUP + j), bg = *(const GAS f32x4*)(cb + j);
        const f32x4 w0v = *(const GAS f32x4*)(cw + DFF + j), w1v = *(const GAS f32x4*)(cw + NUP + DFF + j), w2v = *(const GAS f32x4*)(cw + 2 * (size_t)NUP + DFF + j), bv = *(const GAS f32x4*)(cb + DFF + j);
#pragma unroll
        for (int e = 0; e < 4; ++e) { const float cg = bg[e] + w0g[e] * gp[e] + w1g[e] * gc[e] + w2g[e] * gn[e], cv = bv[e] + w0v[e] * vp[e] + w1v[e] * vc[e] + w2v[e] * vn[e]; o[4 * q + e] = silu_f(cg) * cv; }
    }
    v4u w; w.x = pk2(o[0], o[1]); w.y = pk2(o[2], o[3]); w.z = pk2(o[4], o[5]); w.w = pk2(o[6], o[7]);
    *(GAS v4u*)(act + (size_t)row * DFF + j0) = w;
}

struct Args { const float* in[16]; float* out; unsigned char* ws; };
template <int OFF> __device__ __forceinline__ unsigned long long karg_u64() {
    auto kp = __builtin_amdgcn_kernarg_segment_ptr(); unsigned long long v;
    asm volatile("s_load_dwordx2 %0, %1, %2\n\ts_waitcnt lgkmcnt(0)" : "=s"(v) : "s"(kp), "i"(OFF) : "memory"); return v;
}
#define KIN(i) ((const float*)karg_u64<8 * (i)>())
#define KOUT() ((float*)karg_u64<128>())
#define KWS() ((unsigned char*)karg_u64<136>())
__global__ void __launch_bounds__(NWAVES * 64, 2) fwd_kernel(Args args) {
    extern __shared__ __attribute__((aligned(16))) unsigned char lds[];
    LAS unsigned char* L = (LAS unsigned char*)lds;
    const int G = gridDim.x, bx = blockIdx.x;
    for (int u = threadIdx.x; u < (LDS_BYTES - LDSCTL_OFF) / 4; u += NWAVES * 64) ((LAS unsigned*)(L + LDSCTL_OFF))[u] = 0u;
    __syncthreads();
    XcdBarrier bar = xcd_barrier_post((unsigned*)(KWS() + WS_CTL) + CW_BAR, (volatile LAS unsigned*)(L + MISC_OFF) + 8);
#define GRID_BAR() xcd_barrier(bar)
#ifndef PH_MASK
#define PH_MASK 0xFFFF
#endif
#define PH(k) constexpr ((PH_MASK >> (k)) & 1)
#define TVIEW() int tid = threadIdx.x; asm volatile("" : "+v"(tid)); const int lane = tid & 63, wave = __builtin_amdgcn_readfirstlane(tid >> 6); \
    const int vcu = (G % 8 == 0) ? (bx % 8) * (G / 8) + bx / 8 : bx, gw = vcu * NWAVES + wave, NGW = G * NWAVES; (void)lane; (void)gw; (void)NGW; \
    unsigned char* ws = KWS(); (void)ws

    if PH(0)
    {
        TVIEW();
        LAS float* scr = (LAS float*)(L + RING_OFF + wave * 16384);
        constexpr int I_IN = (DM / 64) * (INW / 32), I_ATT = (NQ / 64) * (DM / 32), I_POOL = (512 / 64) * (1024 / 32), I_OUT = (DM / 64) * (DM / 32), I_UP = (DM / 64) * (NUP / 32);
        constexpr int I_DOWN = (DFF / 64) * (DM / 32), I_DOWN_P0 = I_DOWN - I_DOWN_TAIL;
        constexpr int NITEMS = I_IN + I_ATT + 4 * I_POOL + I_OUT + I_UP + I_DOWN_P0;
        for (int it = gw; it < NITEMS; it += NGW) {
            int r = it;
            if (r < I_IN) { transpose_item_in(KIN(3), (bf16*)(ws + WS_WIN), ws + WS_WIN8, scr, r, lane); continue; } r -= I_IN;
            if (r < I_ATT) { transpose_item_f8(KIN(6), NQ, DM, ws + WS_WATT, NQ, scr, r, lane); continue; } r -= I_ATT;
            if (r < 4 * I_POOL) { const int g = r / I_POOL; transpose_item(KIN(7) + (size_t)g * 512 * 1024, 512, 1024, (bf16*)(ws + WS_WPOOL), 512, g * 1024, scr, r % I_POOL, lane); continue; } r -= 4 * I_POOL;
            if (r < I_OUT) { transpose_item(KIN(9), DM, DM, (bf16*)(ws + WS_WOUT), DM, 0, scr, r, lane); continue; } r -= I_OUT;
            if (r < I_UP) { transpose_item<true>(KIN(11), DM, NUP, (bf16*)(ws + WS_WUP), DM, 0, scr, r, lane, KIN(10)); continue; } r -= I_UP;
            transpose_item(KIN(14), DFF, DM, (bf16*)KOUT(), DFF, 0, scr, I_DOWN_TAIL + r, lane);
        }
        f32x2* rope = (f32x2*)(ws + WS_ROPE);
        for (int e = bx * (NWAVES * 64) + tid; e < 64 * 32; e += G * NWAVES * 64) {
            const int pos = e >> 5, i = e & 31; const float inv_freq = exp2f(-(float)i * (13.287712379549449f / 32.0f)); const float ang = (float)pos * inv_freq;
            f32x2 cs; cs.x = cosf(ang); cs.y = sinf(ang); rope[e] = cs; }
        const float* xp = KIN(0); const float* xs = KIN(1); const float* g_mix = KIN(2); bf16* NB = (bf16*)(ws + WS_R1);
        for (int m = gw; m < T_ALL; m += NGW) rms_row_to_bf16(m < T_P ? xp + (size_t)m * DM : xs + (size_t)(m - T_P) * DM, g_mix, NB + (size_t)m * DM, lane, (unsigned char*)KOUT() + N8_OFF + (size_t)m * DM);
    }
    GRID_BAR();
    if PH(1)
    {
        unsigned char* ws = KWS();
        {
            pg8::Gemm g{(bf16*)(ws + WS_R1), (bf16*)(ws + WS_WIN), DM, DM, DM, 0, 0u}; pg8::StaticOrder S; S.init(T_ALL, NU, G, bx);
            pg8::EpiBf16 E{(bf16*)(ws + WS_U), NU};
            pg8::gemm_phase<pg8::EpiBf16, pg8::StaticOrder, true, true>(L + RING_OFF, g, S, E);
        }
        {
            pg8::Gemm g{(bf16*)((unsigned char*)KOUT() + N8_OFF), (bf16*)(ws + WS_WIN8), DM / 2, DM / 2, DM / 2, 0, 0u}; pg8::StaticOrder S; S.init(T_ALL, INW - NU, G, bx);
            pg8::EpiProj8 E{(bf16*)(ws + WS_Q), (bf16*)(ws + WS_K), (bf16*)(ws + WS_V), (bf16*)(ws + WS_SA), (bf16*)(ws + WS_SP), 1.0f / W8SCALE};
            pg8::gemm_phase<pg8::EpiProj8, pg8::StaticOrder, true, true, true>(L + RING_OFF, g, S, E);
        }
        { constexpr int NWG = (T_ALL / 256) * ((INW - NU) / 256), I_DOWN = (DFF / 64) * (DM / 32);
          const int rem = NWG % G, nh = rem ? G - rem : G, hidx = rem ? bx - rem : bx;
          if (hidx >= 0) { TVIEW(); LAS float* scr = (LAS float*)(L + RING_OFF + wave * 16384); const float* w_down = KIN(14); bf16* WD = (bf16*)KOUT();
              for (int it = hidx * NWAVES + wave; it < I_DOWN_TAIL; it += nh * NWAVES) transpose_item(w_down, DFF, DM, WD, DFF, 0, scr, it, lane); } }
    }
    GRID_BAR();
    if PH(2)
    {
        TVIEW();
        LAS float* scr = (LAS float*)(L + RING_OFF + wave * 16384);
        { const float* qg = KIN(4); const float* kg = KIN(5); const f32x2* rope = (const f32x2*)(ws + WS_ROPE); bf16* QB = (bf16*)(ws + WS_Q); bf16* KB = (bf16*)(ws + WS_K);
          for (int it = gw; it < T_ALL; it += 4 * NGW) normrope_items<4>(QB, KB, qg, kg, rope, it, NGW, T_ALL, lane, ws + WS_K8); }
        { const bf16* VB = (const bf16*)(ws + WS_V); LAS unsigned char* scr8 = L + RING_OFF + wave * 16384;
          for (int it = gw; it < (T_ALL / 64) * 4; it += NGW) vt_block(VB, ws + WS_VT8, it >> 2, it & 3, scr8, lane); }
        { const bf16* UB = (const bf16*)(ws + WS_U); bf16* DB = (bf16*)(ws + WS_D);
          for (int it = gw; it < (T_ALL / PSEG) * 4; it += NGW) { const int m0 = (it >> 2) * PSEG, gr = it & 3;
              if (gr == 0) pool_seg<2>(UB, DB, m0, 0, lane); else if (gr == 1) pool_seg<4>(UB, DB, m0, 1, lane); else if (gr == 2) pool_seg<8>(UB, DB, m0, 2, lane); else pool_seg<16>(UB, DB, m0, 3, lane); } }
    }
    GRID_BAR();
    if PH(3)
    {
        unsigned char* ws = KWS();
        const bf16* QB = (const bf16*)(ws + WS_Q); const bf16* KB = (const bf16*)(ws + WS_K); const bf16* VB = (const bf16*)(ws + WS_V); unsigned char* OB = ws + WS_O;
        const float* qg = KIN(4); const float* rope = (const float*)(ws + WS_ROPE);
        for (int s = bx; s < 6 * 256; s += G) {
            const int r = s >> 8, c = s & 255, xcd = c & 7, idx = c >> 3;
            int b, kvh, h, qb, S_, row0;
            if (r < 4) { const int grp = 4 * xcd + r; b = grp >> 2; kvh = grp & 3; h = kvh * 4 + (idx >> 3); qb = idx & 7; S_ = SEQ_P; row0 = b * SEQ_P; }
            else { b = xcd >> 2; kvh = xcd & 3; const int un = idx + 32 * (r - 4); h = kvh * 4 + (un >> 4); qb = un & 15; S_ = SEQ_S; row0 = T_P + b * SEQ_S; }
            att::attn_unit8(QB + (size_t)(row0 + qb * 256) * NQ + h * 128, ws + WS_K8 + (size_t)row0 * NKV + kvh * 128, ws + WS_VT8 + (size_t)((row0 >> 6) * 4 + kvh) * 8192,
                            OB + (size_t)(row0 + qb * 256) * NQ + h * 128, S_, (LAS char*)(L + RING_OFF), qg, rope, qb * 256);
        }
    }
    GRID_BAR();
    if PH(4)
    {
        unsigned char* ws = KWS();
        pg8::Gemm g{(bf16*)(ws + WS_D), (bf16*)(ws + WS_WPOOL), NU, 512, 512, 2, 1024u}; pg8::StaticOrder S; S.init(T_ALL, DM, G, bx);
        pg8::EpiPool E{(bf16*)(ws + WS_SP), KIN(8)};
        pg8::gemm_phase<pg8::EpiPool, pg8::StaticOrder, false, true>(L + RING_OFF, g, S, E);
    }
    if PH(5)
    {
        unsigned char* ws = KWS();
        pg8::Gemm g{(bf16*)(ws + WS_O), (bf16*)(ws + WS_WATT), NQ / 2, NQ / 2, NQ / 2, 0, 0u}; pg8::StaticOrder S; S.init(T_ALL, DM, G, bx);
        pg8::EpiMerge E{(bf16*)(ws + WS_SA), (const bf16*)(ws + WS_SP), 1.0f / (W8SCALE * att::O8SCALE)};
        pg8::gemm_phase<pg8::EpiMerge, pg8::StaticOrder, false, true, true>(L + RING_OFF, g, S, E);
    }
    GRID_BAR();
    if PH(6)
    {
        unsigned char* ws = KWS();
        pg8::Gemm g{(bf16*)(ws + WS_SA), (bf16*)(ws + WS_WOUT), DM, DM, DM, 0, 0u}; pg8::StaticOrder S; S.init(T_ALL, DM, G, bx);
        pg8::EpiResNorm E{KIN(0), KIN(1), T_P / 256, (bf16*)(ws + WS_R1), (float*)(ws + WS_CTL + CTL_SSQ1)};
        pg8::gemm_phase<pg8::EpiResNorm, pg8::StaticOrder, false, true>(L + RING_OFF, g, S, E);
    }
    GRID_BAR();
    if PH(8)
    {
        unsigned char* ws = KWS();
        pg8::Gemm g{(bf16*)(ws + WS_R1), (bf16*)(ws + WS_WUP), DM, DM, DM, 0, 0u}; pg8::StaticOrder S; S.init(T_ALL, NUP, G, bx);
        pg8::EpiConvGlu E{(bf16*)(ws + WS_ACT), (float*)(ws + WS_HB), KIN(12), KIN(13), DFF, NUP, (const float*)(ws + WS_CTL + CTL_SSQ1), 1.0f / DM, EPS};
        S.lim = (S.nwg / G) * G;
        pg8::gemm_phase<pg8::EpiConvGlu, pg8::StaticOrder, true, true>(L + RING_OFF, g, S, E);
        if (G == 256 && S.nwg - S.lim == 64) {
            const int j = bx >> 3, kp = j & 3, slot = (j >> 2) * 8 + (bx & 7);
            pg8::Gemm g2{(bf16*)(ws + WS_R1) + kp * (DM / 4), (bf16*)(ws + WS_WUP) + kp * (DM / 4), DM, DM, DM / 4, 0, 0u};
            pg8::StaticOrder S2; S2.init(T_ALL, NUP, S.nwg, S.lim + slot);
            pg8::EpiConvGluTail E2{E, (float*)(ws + WS_WIN), (unsigned*)(ws + WS_CTL + CTL_TAILF), bar.bar, kp, slot};
            pg8::gemm_phase<pg8::EpiConvGluTail, pg8::StaticOrder, true, true>(L + RING_OFF, g2, S2, E2);
        } else {
            pg8::StaticOrder S2; S2.init(T_ALL, NUP, S.nwg, S.lim + bx); if (bx >= S.nwg - S.lim) S2.lim = 0;
            pg8::gemm_phase<pg8::EpiConvGlu, pg8::StaticOrder, true, true>(L + RING_OFF, g, S2, E);
        }
    }
    GRID_BAR();
    if PH(8)
    {
        TVIEW();
        const float* HB = (const float*)(ws + WS_HB); bf16* ACT = (bf16*)(ws + WS_ACT); const float* conv_w = KIN(12); const float* conv_b = KIN(13);
        for (int it = gw; it < 96 * 2 * 22; it += NGW) fixup_item(HB, ACT, conv_w, conv_b, it / 44, (it % 44) / 22, it % 22, lane);
    }
    GRID_BAR();
    if PH(8)
    {
        unsigned char* ws = KWS();
        pg8::Gemm g{(bf16*)(ws + WS_ACT), (bf16*)KOUT(), DFF, DFF, DFF, 0, 0u}; pg8::StaticOrder S; S.init(T_ALL, DM, G, bx);
        pg8::EpiResBf16 E{(bf16*)(ws + WS_R1)};
        pg8::gemm_phase<pg8::EpiResBf16, pg8::StaticOrder, false, true>(L + RING_OFF, g, S, E);
    }
    GRID_BAR();
    if PH(9)
    {
        TVIEW();
        float* out = KOUT(); const float* g_fin = KIN(15);
        const bf16* H2 = (const bf16*)(ws + WS_R1);
        for (int m = gw; m < T_ALL; m += NGW) rms_row_bf16_to_f32(H2 + (size_t)m * DM, g_fin, out + (size_t)m * DM, lane);
    }
}

extern "C" void kernel_launch(void* const* d_in, const int* in_sizes, int n_in, void* d_out, int out_size, void* d_ws, size_t ws_size, hipStream_t stream) {
    static int grid = 0;
    if (grid == 0) {
        if (n_in != 16 || out_size != T_ALL * DM || ws_size < WS_END) { fprintf(stderr, "kernel_launch: unexpected shapes (n_in %d out %d ws %zu need %zu); nothing launched\n", n_in, out_size, ws_size, (size_t)WS_END); grid = -1; return; }
        int dev = 0, cus = 0, per_cu = 0;
        if (hipGetDevice(&dev) != hipSuccess || hipDeviceGetAttribute(&cus, hipDeviceAttributeMultiprocessorCount, dev) != hipSuccess) { grid = -1; return; }
        if (hipFuncSetAttribute((const void*)fwd_kernel, hipFuncAttributeMaxDynamicSharedMemorySize, LDS_BYTES) != hipSuccess) { fprintf(stderr, "kernel_launch: hipFuncSetAttribute failed\n"); grid = -1; return; }
        if (hipOccupancyMaxActiveBlocksPerMultiprocessor(&per_cu, (const void*)fwd_kernel, NWAVES * 64, LDS_BYTES) != hipSuccess || per_cu < 1) { fprintf(stderr, "kernel_launch: occupancy query reports %d\n", per_cu); }
        (void)hipGetLastError();
        grid = cus;
    }
    if (grid < 0) return;
    if (hipMemsetAsync((char*)d_ws + WS_CTL, 0, CTL_ZERO_BYTES, stream) != hipSuccess) return;
    Args a{};
    for (int i = 0; i < 16; ++i) a.in[i] = (const float*)d_in[i];
    a.out = (float*)d_out; a.ws = (unsigned char*)d_ws;
    hipLaunchKernelGGL(fwd_kernel, dim3(grid), dim3(NWAVES * 64), LDS_BYTES, stream, a);
}
```
